# Optimizing an MI355X kernel written in HIP

```python
import math
import jax, jax.numpy as jnp
from jax import lax
import numpy as np


D_MODEL = 1024
BATCH = 4
SEQ = 8192
DEPTH = 1

N_HEADS_A = 8
HEAD_DIM = 64
WIDTH_A = N_HEADS_A * HEAD_DIM
MOBA_BLOCK = 256
MOBA_TOPK = 3
Q_CHUNK = 64
N_POOL_GROUPS = 4
POOL_WINDOWS = (2, 4, 8, 16)
WIDTH_B = D_MODEL // 2
POOL_GROUP_DIM = WIDTH_B // N_POOL_GROUPS
N_BRANCHES = 2
D_FF = 4 * D_MODEL
REL_BUCKETS = 32
REL_MAX_DIST = 128
DEEPNORM_ALPHA = (2.0 * DEPTH) ** 0.25
DEEPNORM_BETA = (8.0 * DEPTH) ** -0.25
LN_EPS = 1e-5
NEG_INF = -1e30
IN_COLS = 3 * WIDTH_A + WIDTH_B + N_BRANCHES * D_MODEL

kernel_name = 'moba_pool_hybrid_deepnorm'


def layer_norm(x, g, b):
    xf = x.astype(jnp.float32)
    mu = jnp.mean(xf, axis=-1, keepdims=True)
    var = jnp.mean(jnp.square(xf - mu), axis=-1, keepdims=True)
    return ((xf - mu) * lax.rsqrt(var + LN_EPS) * g + b).astype(x.dtype)


def rel_bucket(dist):
    n = jnp.maximum(dist, 0)
    max_exact = REL_BUCKETS // 2
    nf = jnp.maximum(n, 1).astype(jnp.float32)
    large = max_exact + (jnp.log(nf / max_exact) / math.log(REL_MAX_DIST / max_exact)
                         * (REL_BUCKETS - max_exact)).astype(jnp.int32)
    large = jnp.minimum(large, REL_BUCKETS - 1)
    return jnp.where(n < max_exact, n, large)


def moba_attention(q, k, v, rel_table):
    B, H, S, Dh = q.shape
    nb = -(-S // MOBA_BLOCK)
    s_pad = nb * MOBA_BLOCK
    pad = ((0, 0), (0, 0), (0, s_pad - S), (0, 0))
    q = jnp.pad(q, pad)
    k = jnp.pad(k, pad)
    v = jnp.pad(v, pad)
    k_blk = k.reshape(B, H, nb, MOBA_BLOCK, Dh)
    v_blk = v.reshape(B, H, nb, MOBA_BLOCK, Dh)
    k_mean = jnp.mean(k_blk.astype(jnp.float32), axis=3).astype(k.dtype)
    topk = min(MOBA_TOPK, nb)
    n_chunks = s_pad // Q_CHUNK
    q_ch = q.reshape(B, H, n_chunks, Q_CHUNK, Dh).transpose(2, 0, 1, 3, 4)
    table_t = rel_table.T
    scale = HEAD_DIM ** -0.5
    b_ix = jnp.arange(B)[:, None, None, None]
    h_ix = jnp.arange(H)[None, :, None, None]
    offs = jnp.arange(MOBA_BLOCK)
    blk_ids = jnp.arange(nb)

    def one_chunk(args):
        qc, c = args
        q_pos = c * Q_CHUNK + jnp.arange(Q_CHUNK)
        blk = (c * Q_CHUNK) // MOBA_BLOCK
        gate = jnp.einsum('bhqd,bhnd->bhqn', qc, k_mean,
                          preferred_element_type=jnp.float32)
        gate = jnp.where(blk_ids < blk, gate, NEG_INF)
        _, idx = lax.top_k(gate, topk)
        sel_valid = idx < blk
        k_sel = k_blk[b_ix, h_ix, idx]
        v_sel = v_blk[b_ix, h_ix, idx]
        s_sel = jnp.einsum('bhqd,bhqnld->bhqnl', qc, k_sel,
                           preferred_element_type=jnp.float32) * scale
        k_pos_sel = idx[..., None] * MOBA_BLOCK + offs
        bucket_sel = rel_bucket(q_pos[None, None, :, None, None] - k_pos_sel)
        s_sel = s_sel + table_t[h_ix[..., None], bucket_sel]
        s_sel = jnp.where(sel_valid[..., None], s_sel, NEG_INF)
        k_own = lax.dynamic_index_in_dim(k_blk, blk, axis=2, keepdims=False)
        v_own = lax.dynamic_index_in_dim(v_blk, blk, axis=2, keepdims=False)
        dist_own = q_pos[:, None] - (blk * MOBA_BLOCK + offs)[None, :]
        s_own = jnp.einsum('bhqd,bhld->bhql', qc, k_own,
                           preferred_element_type=jnp.float32) * scale
        s_own = s_own + table_t[:, rel_bucket(dist_own)]
        s_own = jnp.where(dist_own >= 0, s_own, NEG_INF)
        logits = jnp.concatenate(
            [s_sel.reshape(B, H, Q_CHUNK, topk * MOBA_BLOCK), s_own], axis=-1)
        p = jax.nn.softmax(logits, axis=-1)
        p_sel = p[..., :topk * MOBA_BLOCK].reshape(B, H, Q_CHUNK, topk, MOBA_BLOCK).astype(v.dtype)
        p_own = p[..., topk * MOBA_BLOCK:].astype(v.dtype)
        return (jnp.einsum('bhqnl,bhqnld->bhqd', p_sel, v_sel)
                + jnp.einsum('bhql,bhld->bhqd', p_own, v_own))

    out = lax.map(one_chunk, (q_ch, jnp.arange(n_chunks)))
    out = out.transpose(1, 2, 0, 3, 4).reshape(B, H, s_pad, Dh)
    return out[:, :, :S]


def pool_mixer(p, w_pool, pool_scale):
    B, S, _ = p.shape
    pf = p.reshape(B, S, N_POOL_GROUPS, POOL_GROUP_DIM).astype(jnp.float32)
    cs = jnp.pad(jnp.cumsum(pf, axis=1), ((0, 0), (1, 0), (0, 0), (0, 0)))
    t = jnp.arange(S)[:, None]
    win = jnp.array(POOL_WINDOWS, dtype=jnp.int32)[None, :]
    lo = jnp.maximum(t + 1 - win, 0)
    g_ix = jnp.arange(N_POOL_GROUPS)[None, :]
    window_sum = cs[:, 1:] - cs[:, lo, g_ix]
    count = jnp.minimum(t + 1, win).astype(jnp.float32)
    pooled = (window_sum / count[None, :, :, None] - pf).astype(p.dtype)
    mixed = jnp.einsum('bsgc,gcd->bsgd', pooled, w_pool)
    return mixed.reshape(B, S, WIDTH_B) * pool_scale


def setup_inputs(seed: int = 0) -> dict:
    key = jax.random.key(seed)
    ks = jax.random.split(key, 20)
    f32 = jnp.float32

    def nrm(k, shape, scale):
        return jax.random.normal(k, shape, f32) * scale

    x = nrm(ks[0], (BATCH, SEQ, D_MODEL), 1.0)
    col_scale = jnp.ones((IN_COLS,), f32).at[2 * WIDTH_A:3 * WIDTH_A].set(DEEPNORM_BETA)
    w_in = nrm(ks[1], (DEPTH, D_MODEL, IN_COLS), D_MODEL ** -0.5) * col_scale
    b_gate = nrm(ks[2], (DEPTH, N_BRANCHES * D_MODEL), 0.1)
    rel_table = nrm(ks[3], (REL_BUCKETS, N_HEADS_A), 0.5)
    w_pool = nrm(ks[4], (DEPTH, N_POOL_GROUPS, POOL_GROUP_DIM, POOL_GROUP_DIM), POOL_GROUP_DIM ** -0.5)
    pool_scale = 1.0 + nrm(ks[5], (DEPTH, WIDTH_B), 0.1)
    w_o_attn = nrm(ks[6], (DEPTH, WIDTH_A, D_MODEL), WIDTH_A ** -0.5 * DEEPNORM_BETA)
    w_o_pool = nrm(ks[7], (DEPTH, WIDTH_B, D_MODEL), WIDTH_B ** -0.5 * DEEPNORM_BETA)
    w_out = nrm(ks[8], (DEPTH, D_MODEL, D_MODEL), D_MODEL ** -0.5 * DEEPNORM_BETA)
    ln1_g = 1.0 + nrm(ks[9], (DEPTH, D_MODEL), 0.05)
    ln1_b = nrm(ks[10], (DEPTH, D_MODEL), 0.05)
    w_ff1 = nrm(ks[11], (DEPTH, D_MODEL, D_FF), D_MODEL ** -0.5 * DEEPNORM_BETA)
    b_ff1 = nrm(ks[12], (DEPTH, D_FF), 0.02)
    w_ff2 = nrm(ks[13], (DEPTH, D_FF, D_MODEL), D_FF ** -0.5 * DEEPNORM_BETA)
    b_ff2 = nrm(ks[14], (DEPTH, D_MODEL), 0.02)
    ln2_g = 1.0 + nrm(ks[15], (DEPTH, D_MODEL), 0.05)
    ln2_b = nrm(ks[16], (DEPTH, D_MODEL), 0.05)
    return {'x': x, 'w_in': w_in, 'b_gate': b_gate, 'rel_table': rel_table,
            'w_pool': w_pool, 'pool_scale': pool_scale, 'w_o_attn': w_o_attn,
            'w_o_pool': w_o_pool, 'w_out': w_out, 'ln1_g': ln1_g, 'ln1_b': ln1_b,
            'w_ff1': w_ff1, 'b_ff1': b_ff1, 'w_ff2': w_ff2, 'b_ff2': b_ff2,
            'ln2_g': ln2_g, 'ln2_b': ln2_b}


def reference(x, w_in, b_gate, rel_table, w_pool, pool_scale, w_o_attn, w_o_pool,
              w_out, ln1_g, ln1_b, w_ff1, b_ff1, w_ff2, b_ff2, ln2_g, ln2_b):
    B, S, _ = x.shape
    h = x
    split_at = [WIDTH_A, 2 * WIDTH_A, 3 * WIDTH_A, 3 * WIDTH_A + WIDTH_B]
    for l in range(DEPTH):
        proj = jnp.einsum('bsd,de->bse', h, w_in[l])
        q, k, v, p, g = jnp.split(proj, split_at, axis=-1)

        def heads(t):
            return t.reshape(B, S, N_HEADS_A, HEAD_DIM).transpose(0, 2, 1, 3)

        a = moba_attention(heads(q), heads(k), heads(v), rel_table)
        a = a.transpose(0, 2, 1, 3).reshape(B, S, WIDTH_A)
        branch_a = a @ w_o_attn[l]
        branch_b = pool_mixer(p, w_pool[l], pool_scale[l]) @ w_o_pool[l]
        gates = jax.nn.sigmoid((g + b_gate[l]).reshape(B, S, N_BRANCHES, D_MODEL))
        mix = (gates[:, :, 0] * branch_a + gates[:, :, 1] * branch_b) @ w_out[l]
        h = layer_norm(DEEPNORM_ALPHA * h + mix, ln1_g[l], ln1_b[l])
        ff = jnp.square(jax.nn.relu(h @ w_ff1[l] + b_ff1[l])) @ w_ff2[l] + b_ff2[l]
        h = layer_norm(DEEPNORM_ALPHA * h + ff, ln2_g[l], ln2_b[l])
    return h
```

```cpp
#define N_LAUNCHES 1
#include <hip/hip_runtime.h>
#include <cstdio>
#include <cstdint>
constexpr int MROWS = 32768;
namespace pg8 {
#define PG8_LAS __attribute__((address_space(3)))
typedef unsigned short bf16_t;
typedef short bf16x8 __attribute__((ext_vector_type(8)));
typedef float f32x4 __attribute__((ext_vector_type(4)));
typedef unsigned u32x4 __attribute__((ext_vector_type(4)));
constexpr int BM = 256, BK = 64, HALF = 128, HTB = HALF * BK * 2  , STAGE_BYTES = 8 * HTB, NXCD = 8, WGM = 8;

__host__ __device__ __forceinline__ int lds_byte(int r, int c) { const int st = (r >> 4) * 2 + (c >> 5), rr = r & 15, cc = c & 31, ob = rr * 64 + cc * 2; return st * 1024 + (ob ^ (((ob >> 9) & 1) << 5)); }
__host__ __device__ __forceinline__ void stage_rc(int b, int& R, int& C) { const int st = b / 1024, sb = b % 1024, swz = sb ^ (((sb >> 9) & 1) << 5); R = (st >> 1) * 16 + swz / 64; C = (st & 1) * 32 + (swz % 64) / 2; }
__host__ __device__ __forceinline__ int perm32(int rho) { const int n = rho >> 4, i = rho & 15; return 8 * (i >> 2) + 4 * n + (i & 3); }

struct Unit { int pm, pn; };
struct Gemm { const bf16_t* A; const bf16_t* Bt; int M, N, K; };

struct StaticOrder {
    int nM, nN, nwg, G, c;
    __host__ __device__ void init(int M, int N, int G_, int c_) { nM = M / BM; nN = N / BM; nwg = nM * nN; G = G_; c = c_; }
    __host__ __device__ bool next(int i, Unit& u) const {
        const long L = (long)i * G + c; if (L >= nwg) return false;
        int wgid = (int)L; { const int q = nwg / NXCD, r = nwg % NXCD, xcd = wgid % NXCD, off = wgid / NXCD; wgid = (xcd < r ? xcd * (q + 1) : r * (q + 1) + (xcd - r) * q) + off; }
        const int nig = WGM * nN, gid = wgid / nig, fm = gid * WGM, gsz = (nM - fm) < WGM ? (nM - fm) : WGM;
        u.pm = fm + ((wgid % nig) % gsz); u.pn = (wgid % nig) / gsz; return true;
    }
    __device__ __forceinline__ void a_ready(const Unit&) const {}
    __device__ __forceinline__ void done(const Unit&) const {}
};

typedef float f32x2_t __attribute__((ext_vector_type(2))); typedef __bf16 bf16x2_t __attribute__((ext_vector_type(2)));
__device__ __forceinline__ unsigned cvt_pk_bf16(float lo, float hi) { f32x2_t v = {lo, hi}; bf16x2_t b = __builtin_convertvector(v, bf16x2_t); return __builtin_bit_cast(unsigned, b); }
__device__ __forceinline__ float bf_lo(unsigned w) { return __uint_as_float(w << 16); }
__device__ __forceinline__ float bf_hi(unsigned w) { return __uint_as_float(w & 0xffff0000u); }
__device__ __forceinline__ float sigmoidf_fast(float x) { return __builtin_amdgcn_rcpf(1.0f + __builtin_amdgcn_exp2f(-1.4426950408889634f * x)); }
__device__ __forceinline__ u32x4 pack8(const f32x4 v0, const f32x4 v1) { u32x4 w; w.x = cvt_pk_bf16(v0[0], v0[1]); w.y = cvt_pk_bf16(v0[2], v0[3]); w.z = cvt_pk_bf16(v1[0], v1[1]); w.w = cvt_pk_bf16(v1[2], v1[3]); return w; }

struct EpiProj {
    static constexpr bool PERM = true, AFTER_DRAIN = false;
    bf16_t* QKVP; bf16_t* G; const float* bgate; float* ksum; float qscale;
    __device__ __forceinline__ void operator()(const f32x4 (&acc)[2][2][4][2], const Unit& u, int wr, int wc, int fr, int fq) const {
        const int row0 = u.pm * BM + wr * 64 + fr;
        if (u.pn < 8) {
            const int t = u.pn >> 1;
            bf16_t* base = QKVP + (size_t)t * ((size_t)MROWS * 512);
            const int col0 = (u.pn & 1) * 256 + wc * 32 + 8 * fq;
            const float sc = (t == 0) ? qscale : 1.f;
#pragma unroll
            for (int ai = 0; ai < 2; ++ai)
#pragma unroll
                for (int m = 0; m < 4; ++m) { bf16_t* rowp = base + (size_t)(row0 + ai * HALF + m * 16) * 512 + col0;
#pragma unroll
                    for (int bj = 0; bj < 2; ++bj) *(u32x4*)(rowp + bj * HALF) = pack8(acc[ai][bj][m][0] * sc, acc[ai][bj][m][1] * sc); }
            if (t == 1) {
#pragma unroll
                for (int bj = 0; bj < 2; ++bj)
#pragma unroll
                    for (int n = 0; n < 2; ++n) { f32x4 s = (f32x4){0.f, 0.f, 0.f, 0.f};
#pragma unroll
                        for (int ai = 0; ai < 2; ++ai)
#pragma unroll
                            for (int m = 0; m < 4; ++m) s += acc[ai][bj][m][n];
#pragma unroll
                        for (int e = 0; e < 4; ++e) { float v = s[e]; v += __shfl_xor(v, 1); v += __shfl_xor(v, 2); v += __shfl_xor(v, 4); v += __shfl_xor(v, 8);
                            if (fr == 0) unsafeAtomicAdd(ksum + (size_t)u.pm * 512 + col0 + bj * HALF + 4 * n + e, v); } }
            }
        } else {
            const int gcol0 = (u.pn - 8) * 256 + wc * 32 + 8 * fq;
            f32x4 bv[2][2];
#pragma unroll
            for (int bj = 0; bj < 2; ++bj)
#pragma unroll
                for (int n = 0; n < 2; ++n) bv[bj][n] = *(const f32x4*)(bgate + gcol0 + bj * HALF + 4 * n);
#pragma unroll
            for (int ai = 0; ai < 2; ++ai)
#pragma unroll
                for (int m = 0; m < 4; ++m) { bf16_t* rowp = G + (size_t)(row0 + ai * HALF + m * 16) * 2048 + gcol0;
#pragma unroll
                    for (int bj = 0; bj < 2; ++bj) { f32x4 v0 = acc[ai][bj][m][0] + bv[bj][0], v1 = acc[ai][bj][m][1] + bv[bj][1];
#pragma unroll
                        for (int e = 0; e < 4; ++e) { v0[e] = sigmoidf_fast(v0[e]); v1[e] = sigmoidf_fast(v1[e]); }
                        *(u32x4*)(rowp + bj * HALF) = pack8(v0, v1); } }
        }
    }
};
template <bool ADD> struct EpiBranch {
    static constexpr bool PERM = true, AFTER_DRAIN = false;
    bf16_t* U; const bf16_t* G;
    __device__ __forceinline__ void operator()(const f32x4 (&acc)[2][2][4][2], const Unit& u, int wr, int wc, int fr, int fq) const {
        const int row0 = u.pm * BM + wr * 64 + fr, col0 = u.pn * BM + wc * 32 + 8 * fq;
#pragma unroll
        for (int ai = 0; ai < 2; ++ai)
#pragma unroll
            for (int m = 0; m < 4; ++m) { const size_t r = (size_t)(row0 + ai * HALF + m * 16);
#pragma unroll
                for (int bj = 0; bj < 2; ++bj) { const int c = col0 + bj * HALF;
                    const u32x4 g = *(const u32x4*)(G + r * 2048 + (ADD ? 0 : 1024) + c);
                    f32x4 v0 = acc[ai][bj][m][0], v1 = acc[ai][bj][m][1];
                    v0[0] *= bf_lo(g.x); v0[1] *= bf_hi(g.x); v0[2] *= bf_lo(g.y); v0[3] *= bf_hi(g.y);
                    v1[0] *= bf_lo(g.z); v1[1] *= bf_hi(g.z); v1[2] *= bf_lo(g.w); v1[3] *= bf_hi(g.w);
                    if (ADD) { const u32x4 o = *(const u32x4*)(U + r * 1024 + c);
                        v0[0] += bf_lo(o.x); v0[1] += bf_hi(o.x); v0[2] += bf_lo(o.y); v0[3] += bf_hi(o.y);
                        v1[0] += bf_lo(o.z); v1[1] += bf_hi(o.z); v1[2] += bf_lo(o.w); v1[3] += bf_hi(o.w); }
                    *(u32x4*)(U + r * 1024 + c) = pack8(v0, v1); } }
    }
};
struct EpiMix {
    static constexpr bool PERM = false, AFTER_DRAIN = false;
    const float* X; float* H; float alpha;
    __device__ __forceinline__ void operator()(const f32x4 (&acc)[2][2][4][2], const Unit& u, int wr, int wc, int fr, int fq) const {
        const int row0 = u.pm * BM + wr * 64 + fr, col0 = u.pn * BM + wc * 32 + 4 * fq;
#pragma unroll
        for (int ai = 0; ai < 2; ++ai)
#pragma unroll
            for (int m = 0; m < 4; ++m) { const size_t off = (size_t)(row0 + ai * HALF + m * 16) * 1024 + col0;
#pragma unroll
                for (int bj = 0; bj < 2; ++bj)
#pragma unroll
                    for (int n = 0; n < 2; ++n) { const f32x4 xv = *(const f32x4*)(X + off + bj * HALF + n * 16); *(f32x4*)(H + off + bj * HALF + n * 16) = xv * alpha + acc[ai][bj][m][n]; } }
    }
};
struct EpiFF1 {
    static constexpr bool PERM = true, AFTER_DRAIN = false;
    bf16_t* F; const float* bias;
    __device__ __forceinline__ void operator()(const f32x4 (&acc)[2][2][4][2], const Unit& u, int wr, int wc, int fr, int fq) const {
        const int row0 = u.pm * BM + wr * 64 + fr, col0 = u.pn * BM + wc * 32 + 8 * fq;
        f32x4 bv[2][2];
#pragma unroll
        for (int bj = 0; bj < 2; ++bj)
#pragma unroll
            for (int n = 0; n < 2; ++n) bv[bj][n] = *(const f32x4*)(bias + col0 + bj * HALF + 4 * n);
#pragma unroll
        for (int ai = 0; ai < 2; ++ai)
#pragma unroll
            for (int m = 0; m < 4; ++m) { bf16_t* rowp = F + (size_t)(row0 + ai * HALF + m * 16) * 4096 + col0;
#pragma unroll
                for (int bj = 0; bj < 2; ++bj) { f32x4 v0 = acc[ai][bj][m][0] + bv[bj][0], v1 = acc[ai][bj][m][1] + bv[bj][1];
#pragma unroll
                    for (int e = 0; e < 4; ++e) { const float a = fmaxf(v0[e], 0.f), b = fmaxf(v1[e], 0.f); v0[e] = a * a; v1[e] = b * b; }
                    *(u32x4*)(rowp + bj * HALF) = pack8(v0, v1); } }
    }
};
struct EpiFF2 {
    static constexpr bool PERM = false, AFTER_DRAIN = false;
    const float* HPRE; const float* stats; const float* g1; const float* bt1; const float* b2; float* OUT; float alpha;
    __device__ __forceinline__ void operator()(const f32x4 (&acc)[2][2][4][2], const Unit& u, int wr, int wc, int fr, int fq) const {
        typedef float f32x2v __attribute__((ext_vector_type(2)));
        const int row0 = u.pm * BM + wr * 64 + fr, col0 = u.pn * BM + wc * 32 + 4 * fq;
        f32x4 c1[2][2], c0[2][2];
#pragma unroll
        for (int bj = 0; bj < 2; ++bj)
#pragma unroll
            for (int n = 0; n < 2; ++n) { const int c = col0 + bj * HALF + n * 16; c1[bj][n] = *(const f32x4*)(g1 + c) * alpha; c0[bj][n] = *(const f32x4*)(bt1 + c) * alpha + *(const f32x4*)(b2 + c); }
#pragma unroll
        for (int ai = 0; ai < 2; ++ai)
#pragma unroll
            for (int m = 0; m < 4; ++m) { const size_t r = (size_t)(row0 + ai * HALF + m * 16); const f32x2v st = *(const f32x2v*)(stats + 2 * r); const size_t off = r * 1024 + col0;
#pragma unroll
                for (int bj = 0; bj < 2; ++bj)
#pragma unroll
                    for (int n = 0; n < 2; ++n) { const f32x4 hp = *(const f32x4*)(HPRE + off + bj * HALF + n * 16);
                        *(f32x4*)(OUT + off + bj * HALF + n * 16) = acc[ai][bj][m][n] + c0[bj][n] + ((hp - st.x) * st.y) * c1[bj][n]; } }
    }
};
template <class Epi, class Sched, bool ALIGN_EPI = false, bool SP2 = false>
__device__ __forceinline__ void gemm_phase(PG8_LAS unsigned char* lds, const Gemm g, const Sched& S, const Epi& E) {
    const int tid = threadIdx.x, wid = __builtin_amdgcn_readfirstlane(tid >> 6), lane = tid & 63, wr = wid >> 2, wc = wid & 3, fr = lane & 15, fq = lane >> 4;
    const int K = g.K, nt = K / BK;
    unsigned voffA[2], voffB[2];
#pragma unroll
    for (int i = 0; i < 2; ++i) { int R, C; stage_rc(tid * 16 + i * 8192, R, C); const int Rb = Epi::PERM ? ((R & ~31) + perm32(R & 31)) : R;
        voffA[i] = (unsigned)(R * K + C) * 2u; voffB[i] = (unsigned)(Rb * K + C) * 2u; }
    const size_t kstep = (size_t)(BK * 2);
    const size_t hstep = (size_t)HALF * K * 2;
    const size_t tstep = 2 * hstep;
    const unsigned ldsw = (unsigned)wid * 1024u;
    const int aoff = lds_byte(wr * 64 + fr, fq * 8), boff = lds_byte(wc * 32 + fr, fq * 8);
#define PG8_SA(b, h) (((b) * 2 + (h)) * HTB)
#define PG8_SB(b, h) ((4 + (b) * 2 + (h)) * HTB)
#define PG8_STAGE(bufoff, gbase, voff) do { _Pragma("unroll") for (int _i = 0; _i < 2; ++_i) \
        __builtin_amdgcn_global_load_lds((const unsigned*)((const char*)(gbase) + (voff)[_i]), (PG8_LAS unsigned*)(lds + (bufoff) + ldsw + _i * 8192), 16, 0, 0); } while (0)
#define PG8_LDA(dst, b, h) do { _Pragma("unroll") for (int m = 0; m < 4; ++m) _Pragma("unroll") for (int k = 0; k < 2; ++k) dst[m][k] = *(const PG8_LAS bf16x8*)(lds + PG8_SA(b, h) + aoff + m * 2048 + k * 1024); } while (0)
#define PG8_LDB(dst, b, h) do { _Pragma("unroll") for (int n = 0; n < 2; ++n) _Pragma("unroll") for (int k = 0; k < 2; ++k) dst[n][k] = *(const PG8_LAS bf16x8*)(lds + PG8_SB(b, h) + boff + n * 2048 + k * 1024); } while (0)
#define PG8_MMA(ai, bj, At, Bt) do { __builtin_amdgcn_s_setprio(1); _Pragma("unroll") for (int m = 0; m < 4; ++m) _Pragma("unroll") for (int n = 0; n < 2; ++n) _Pragma("unroll") for (int k = 0; k < 2; ++k) \
        acc[ai][bj][m][n] = __builtin_amdgcn_mfma_f32_16x16x32_bf16(Bt[n][k], At[m][k], acc[ai][bj][m][n], 0, 0, 0); __builtin_amdgcn_s_setprio(0); } while (0)
#define PG8_WAIT_V(n) asm volatile("s_waitcnt vmcnt(" #n ")" ::: "memory")
#define PG8_WAIT_L(n) asm volatile("s_waitcnt lgkmcnt(" #n ")" ::: "memory")
#define PG8_BAR __builtin_amdgcn_s_barrier()
#define PG8_SCHED __builtin_amdgcn_sched_barrier(0)
    Unit cur, nxt; int ui = 0;
    if (!S.next(0, cur)) return;
    f32x4 acc[2][2][4][2];
#pragma unroll
    for (int a = 0; a < 2; ++a)
#pragma unroll
        for (int b = 0; b < 2; ++b)
#pragma unroll
            for (int m = 0; m < 4; ++m)
#pragma unroll
                for (int n = 0; n < 2; ++n) acc[a][b][m][n] = (f32x4){0.f, 0.f, 0.f, 0.f};
    bf16x8 At[4][2], B0[2][2], B1[2][2];
    const char* cA = (const char*)g.A + (size_t)cur.pm * tstep; const char* cB = (const char*)g.Bt + (size_t)cur.pn * tstep;
    S.a_ready(cur);
    if constexpr (SP2) {
        PG8_STAGE(PG8_SB(0, 0), cB, voffB); PG8_STAGE(PG8_SB(0, 1), cB + hstep, voffB); PG8_STAGE(PG8_SA(0, 0), cA, voffA); PG8_STAGE(PG8_SA(0, 1), cA + hstep, voffA);
        if (wr == 1) PG8_BAR;
        PG8_WAIT_V(2); PG8_BAR;
        PG8_STAGE(PG8_SB(1, 0), cB + kstep, voffB); PG8_STAGE(PG8_SA(1, 0), cA + kstep, voffA); PG8_STAGE(PG8_SB(1, 1), cB + hstep + kstep, voffB);
        PG8_WAIT_V(6); PG8_BAR;
    } else {
        PG8_STAGE(PG8_SB(0, 0), cB, voffB); PG8_STAGE(PG8_SA(0, 0), cA, voffA); PG8_STAGE(PG8_SB(0, 1), cB + hstep, voffB); PG8_STAGE(PG8_SA(0, 1), cA + hstep, voffA);
        if (wr == 1) PG8_BAR;
        PG8_WAIT_V(4); PG8_BAR;
        PG8_STAGE(PG8_SB(1, 0), cB + kstep, voffB); PG8_STAGE(PG8_SA(1, 0), cA + kstep, voffA); PG8_STAGE(PG8_SB(1, 1), cB + hstep + kstep, voffB);
        PG8_WAIT_V(6); PG8_BAR;
    }
    for (;;) {
        const bool has_next = S.next(ui + 1, nxt);
        const char* nA = has_next ? (const char*)g.A + (size_t)nxt.pm * tstep : cA; const char* nB = has_next ? (const char*)g.Bt + (size_t)nxt.pn * tstep : cB;
        for (int t = 0; t < nt; t += 2) {
            const bool last = (t == nt - 2);
            const char* a1 = cA + (size_t)(t + 1) * kstep;
            const char* a2 = last ? nA : cA + (size_t)(t + 2) * kstep; const char* b2 = last ? nB : cB + (size_t)(t + 2) * kstep;
            const char* a3 = a2 + kstep; const char* b3 = b2 + kstep;
            if (last && has_next) S.a_ready(nxt);
            if constexpr (SP2) {
            PG8_LDB(B0, 0, 0); PG8_LDB(B1, 0, 1); PG8_SCHED; PG8_LDA(At, 0, 0); PG8_STAGE(PG8_SA(1, 1), a1 + hstep, voffA);
            PG8_WAIT_V(8); PG8_WAIT_L(0); PG8_BAR; PG8_MMA(0, 0, At, B0); PG8_MMA(0, 1, At, B1); PG8_BAR; PG8_SCHED;
            PG8_LDA(At, 0, 1); PG8_STAGE(PG8_SB(0, 0), b2, voffB); PG8_STAGE(PG8_SB(0, 1), b2 + hstep, voffB); PG8_STAGE(PG8_SA(0, 0), a2, voffA);
            PG8_WAIT_V(8); PG8_WAIT_L(0); PG8_BAR; PG8_MMA(1, 0, At, B0); PG8_MMA(1, 1, At, B1); PG8_BAR; PG8_SCHED;
            PG8_LDB(B0, 1, 0); PG8_LDB(B1, 1, 1); PG8_SCHED; PG8_LDA(At, 1, 0); PG8_STAGE(PG8_SA(0, 1), a2 + hstep, voffA);
            PG8_WAIT_V(8); PG8_WAIT_L(0); PG8_BAR; PG8_MMA(0, 0, At, B0); PG8_MMA(0, 1, At, B1); PG8_BAR; PG8_SCHED;
            PG8_LDA(At, 1, 1); PG8_STAGE(PG8_SB(1, 0), b3, voffB); PG8_STAGE(PG8_SB(1, 1), b3 + hstep, voffB); PG8_STAGE(PG8_SA(1, 0), a3, voffA);
            PG8_WAIT_V(8); PG8_WAIT_L(0); PG8_BAR; PG8_MMA(1, 0, At, B0); PG8_MMA(1, 1, At, B1); PG8_BAR; PG8_SCHED;
            } else {
            PG8_LDB(B0, 0, 0); PG8_SCHED; PG8_LDA(At, 0, 0); PG8_STAGE(PG8_SA(1, 1), a1 + hstep, voffA);
            PG8_WAIT_L(8); PG8_BAR; PG8_WAIT_L(0); PG8_MMA(0, 0, At, B0); PG8_BAR; PG8_SCHED;
            PG8_LDB(B1, 0, 1); PG8_STAGE(PG8_SB(0, 0), b2, voffB);
            PG8_BAR; PG8_WAIT_L(0); PG8_MMA(0, 1, At, B1); PG8_BAR;
            PG8_LDA(At, 0, 1); PG8_STAGE(PG8_SA(0, 0), a2, voffA);
            PG8_BAR; PG8_WAIT_L(0); PG8_MMA(1, 0, At, B0); PG8_BAR; PG8_SCHED;
            PG8_STAGE(PG8_SB(0, 1), b2 + hstep, voffB);
            PG8_WAIT_V(6); PG8_BAR; PG8_MMA(1, 1, At, B1); PG8_BAR;
            PG8_LDB(B0, 1, 0); PG8_SCHED; PG8_LDA(At, 1, 0); PG8_STAGE(PG8_SA(0, 1), a2 + hstep, voffA);
            PG8_WAIT_L(8); PG8_BAR; PG8_WAIT_L(0); PG8_MMA(0, 0, At, B0); PG8_BAR; PG8_SCHED;
            PG8_LDB(B1, 1, 1); PG8_STAGE(PG8_SB(1, 0), b3, voffB);
            PG8_BAR; PG8_WAIT_L(0); PG8_MMA(0, 1, At, B1); PG8_BAR;
            PG8_LDA(At, 1, 1); PG8_STAGE(PG8_SA(1, 0), a3, voffA);
            PG8_BAR; PG8_WAIT_L(0); PG8_MMA(1, 0, At, B0); PG8_BAR; PG8_SCHED;
            PG8_STAGE(PG8_SB(1, 1), b3 + hstep, voffB);
            PG8_WAIT_V(6); PG8_BAR; PG8_MMA(1, 1, At, B1); PG8_BAR;
            }
        }
        if constexpr (ALIGN_EPI) { if (wr == 0) PG8_BAR; }
        if constexpr (!Epi::AFTER_DRAIN) { E(acc, cur, wr, wc, fr, fq); S.done(cur); }
        if (!has_next) break;
#pragma unroll
        for (int a = 0; a < 2; ++a)
#pragma unroll
            for (int b = 0; b < 2; ++b)
#pragma unroll
                for (int m = 0; m < 4; ++m)
#pragma unroll
                    for (int n = 0; n < 2; ++n) acc[a][b][m][n] = (f32x4){0.f, 0.f, 0.f, 0.f};
        cur = nxt; cA = nA; cB = nB; ++ui;
        if constexpr (ALIGN_EPI) { if (wr == 1) PG8_BAR; }
    }
    PG8_WAIT_V(0);
    if constexpr (!ALIGN_EPI) { if (wr == 0) PG8_BAR; }
    PG8_BAR;
    if constexpr (Epi::AFTER_DRAIN) { E.fused(acc, cur, wr, wc, fr, fq, lds, wid, lane); S.done(cur); }
#undef PG8_SA
#undef PG8_SB
#undef PG8_STAGE
#undef PG8_LDA
#undef PG8_LDB
#undef PG8_MMA
#undef PG8_WAIT_V
#undef PG8_WAIT_L
#undef PG8_BAR
#undef PG8_SCHED
}
}
constexpr int NWAVES = 8;
constexpr int SEQ = 8192, NB = 4, D = 1024, NH = 8, HD = 64, WA = 512, FF = 4096, NCOL = 4096, BLK = 256, NBLK = SEQ / BLK;
constexpr int M = MROWS;
constexpr float LN_EPS = 1e-5f;
constexpr float ALPHA = 1.189207115002721f;
constexpr float LOG2E = 1.4426950408889634f;
constexpr float QSCALE = 0.125f * LOG2E;
constexpr size_t MiB = 1u << 20;
constexpr size_t WS_CTL = 0, CTL_ZERO_BYTES = 1 * MiB;
constexpr size_t WS_KSUM = 512 * 1024;
constexpr size_t WS_STATS = 1 * MiB;
constexpr size_t WS_WIN = 4 * MiB, WS_WOA = 12 * MiB, WS_WPB = 13 * MiB, WS_WOUT = 14 * MiB, WS_W1 = 16 * MiB, WS_W2 = 24 * MiB;
constexpr size_t WS_XB = 32 * MiB;
constexpr size_t WS_QKVP = 96 * MiB;
constexpr size_t WS_G = 224 * MiB;
constexpr size_t WS_POOLED = 352 * MiB, WS_ATT = 384 * MiB, WS_U = 416 * MiB;
constexpr size_t WS_HPRE = 32 * MiB;
constexpr size_t WS_HB = 160 * MiB;
constexpr size_t WS_F = 224 * MiB;
constexpr size_t WS_END = 480 * MiB;
constexpr int CW_BAR = 4096;
constexpr int RING_OFF = 0, RING_BYTES = 131072;
constexpr int LDSCTL_OFF = RING_BYTES, MISC_OFF = LDSCTL_OFF + 320;
constexpr int LDS_BYTES = 147456;

#define GAS __attribute__((address_space(1)))
#define LAS __attribute__((address_space(3)))
typedef unsigned short bf16;
typedef unsigned v4u __attribute__((ext_vector_type(4)));
typedef float f32x4 __attribute__((ext_vector_type(4)));
typedef GAS unsigned gu32;
#define LDS_WAIT() asm volatile("s_waitcnt lgkmcnt(0)" ::: "memory")
#define VM_WAIT() asm volatile("s_waitcnt vmcnt(0)" ::: "memory")
__device__ __forceinline__ unsigned f2bf(float f) { unsigned u = __builtin_bit_cast(unsigned, f); return (u + 0x7fffu + ((u >> 16) & 1u)) >> 16; }
__device__ __forceinline__ unsigned pk2(float lo, float hi) { return f2bf(lo) | (f2bf(hi) << 16); }
__device__ __forceinline__ float bflo(unsigned w) { return __uint_as_float(w << 16); }
__device__ __forceinline__ float bfhi(unsigned w) { return __uint_as_float(w & 0xffff0000u); }
#define XB_TMO      128
#define XB_XCNT(j)  (256  + 64 * (j))
#define XB_XSUB(j)  (1280 + 64 * (j))
#define XB_XGEN(j)  (2304 + 64 * (j))
#define XB_TOP      3328
#define XB_TOPGEN   3392
#define XCD_BAR_WORDS 3456
#define XB_SPIN_CAP (1u << 24)

__device__ __forceinline__ unsigned xb_ld(unsigned* p)              { return __hip_atomic_load(p, __ATOMIC_RELAXED, __HIP_MEMORY_SCOPE_AGENT); }
__device__ __forceinline__ unsigned xb_add(unsigned* p, unsigned v) { return __hip_atomic_fetch_add(p, v, __ATOMIC_RELAXED, __HIP_MEMORY_SCOPE_AGENT); }
__device__ __forceinline__ unsigned xb_xcc_id() { return (unsigned)__builtin_amdgcn_s_getreg((3 << 11) | 20) & 0xFu; }
#define XB_SPIN(cond, bar) do { unsigned _sp = 0; while (cond) { __builtin_amdgcn_s_sleep(1); \
    if ((++_sp & 255u) == 0u) { if (xb_ld(&(bar)[XB_TMO])) break; if (_sp > XB_SPIN_CAP) { atomicAdd(&(bar)[XB_TMO], 1u); break; } } } } while (0)

struct XcdBarrier {
    unsigned* bar; unsigned x;
    volatile LAS unsigned* st;
};

__device__ __forceinline__ XcdBarrier xcd_barrier_post(unsigned* bar, volatile LAS unsigned* st) {
    XcdBarrier b; b.bar = bar; b.x = xb_xcc_id(); b.st = st;
    if (threadIdx.x == 0) (void)xb_add(&bar[XB_XCNT(b.x)], 1u);
    return b;
}
__device__ __forceinline__ void xcd_barrier_complete(unsigned* bar, unsigned x, unsigned& nloc, unsigned& nx) {
    const unsigned G = gridDim.x * gridDim.y * gridDim.z;
    unsigned sum, cnt, mine, sp = 0u;
    for (;;) {
        sum = 0u; cnt = 0u; mine = 0u;
#pragma unroll
        for (unsigned j = 0; j < 16; ++j) { const unsigned c = xb_ld(&bar[XB_XCNT(j)]); sum += c; cnt += (c > 0u) ? 1u : 0u; mine = (j == x) ? c : mine; }
        if (sum == G) break;
        __builtin_amdgcn_s_sleep(1);
        if ((++sp & 255u) == 0u) { if (xb_ld(&bar[XB_TMO])) break; if (sp > XB_SPIN_CAP) { atomicAdd(&bar[XB_TMO], 1u); break; } }
    }
    nloc = mine > 0u ? mine : 1u; nx = cnt > 0u ? cnt : 1u;
}

__device__ __forceinline__ void xcd_barrier(const XcdBarrier& b) {
    asm volatile("s_waitcnt vmcnt(0)" ::: "memory");
    __syncthreads();
    if (threadIdx.x == 0) {
        unsigned* bar = b.bar;
        __builtin_amdgcn_s_waitcnt(0);
        unsigned nloc = b.st[0], nx = b.st[1];
        if (nloc == 0u) { xcd_barrier_complete(bar, b.x, nloc, nx); b.st[0] = nloc; b.st[1] = nx; }
        const unsigned old = xb_add(&bar[XB_XSUB(b.x)], 1u);
        const unsigned gen = old / nloc;
        if (old + 1u == (gen + 1u) * nloc) {
            __builtin_amdgcn_fence(__ATOMIC_RELEASE, "agent");
            asm volatile("s_waitcnt vmcnt(0)" ::: "memory");
            const unsigned og = xb_add(&bar[XB_TOP], 1u);
            const unsigned tg = og / nx;
            if (og + 1u == (tg + 1u) * nx) xb_add(&bar[XB_TOPGEN], 1u);
            else XB_SPIN(xb_ld(&bar[XB_TOPGEN]) == tg, bar);
            __builtin_amdgcn_fence(__ATOMIC_ACQUIRE, "agent");
            xb_add(&bar[XB_XGEN(b.x)], 1u);
            asm volatile("s_waitcnt vmcnt(0)" ::: "memory");
        } else {
            XB_SPIN(xb_ld(&bar[XB_XGEN(b.x)]) == gen, bar);
            __builtin_amdgcn_fence(__ATOMIC_ACQUIRE, "agent");
            asm volatile("s_waitcnt vmcnt(0)" ::: "memory");
        }
    }
    __syncthreads();
}
#ifndef N_LAUNCHES
#define N_LAUNCHES 9
#endif
struct Args { const float* in[17]; float* out; unsigned char* ws; int ph_lo, ph_hi; };
struct Frame {
    LAS unsigned char* lds; volatile LAS unsigned* MISC; gu32* ctl;
    int tid, lane, wave, vcu, G;
};
__device__ __forceinline__ float wave_sum(float v) {
#pragma unroll
    for (int o = 1; o < 64; o <<= 1) v += __shfl_xor(v, o);
    return v;
}
__device__ __forceinline__ float wave_max(float v) {
#pragma unroll
    for (int o = 1; o < 64; o <<= 1) v = fmaxf(v, __shfl_xor(v, o));
    return v;
}
__device__ __forceinline__ void p0_transpose_item(const float* W, int K, int N, bf16* WT, LAS float* scr, int item, int lane) {
    const int nblk = N / 32, kb = item / nblk, nb = item % nblk, k0 = 64 * kb, n0 = 32 * nb;
#pragma unroll 8
    for (int i = 0; i < 32; ++i) { const int kk = 2 * i + (lane >> 5); scr[kk * 33 + (lane & 31)] = W[(size_t)(k0 + kk) * N + n0 + (lane & 31)]; }
    LDS_WAIT(); asm volatile("" ::: "memory");
    const int c = lane & 7;
#pragma unroll
    for (int j = 0; j < 4; ++j) { const int n = (lane >> 3) + 8 * j; const LAS float* s = scr + (8 * c) * 33 + n;
        v4u o; o.x = pk2(s[0 * 33], s[1 * 33]); o.y = pk2(s[2 * 33], s[3 * 33]); o.z = pk2(s[4 * 33], s[5 * 33]); o.w = pk2(s[6 * 33], s[7 * 33]);
        *(GAS v4u*)(WT + (size_t)(n0 + n) * K + k0 + 8 * c) = o; }
    LDS_WAIT(); asm volatile("" ::: "memory");
}
__device__ __forceinline__ void p0_wpb_item(const float* wpool, const float* pscale, const float* wop, bf16* WT, int item, int lane) {
    const int nb = item & 15, kb = item >> 4, n = nb * 64 + lane, k0 = kb * 8, g = k0 >> 7, c0 = k0 & 127;
    float acc[8];
#pragma unroll
    for (int i = 0; i < 8; ++i) acc[i] = 0.f;
    const float* wp = wpool + ((size_t)g * 128 + c0) * 128;
    for (int d = 0; d < 128; ++d) {
        const float wo = wop[(size_t)(g * 128 + d) * 1024 + n] * pscale[g * 128 + d];
#pragma unroll
        for (int i = 0; i < 8; ++i) acc[i] += wp[i * 128 + d] * wo;
    }
    v4u o; o.x = pk2(acc[0], acc[1]); o.y = pk2(acc[2], acc[3]); o.z = pk2(acc[4], acc[5]); o.w = pk2(acc[6], acc[7]);
    *(GAS v4u*)(WT + (size_t)n * 512 + k0) = o;
}
__device__ __forceinline__ void p0_prologue(Frame& F, const Args& a) {
    unsigned char* ws = a.ws;
    LAS float* scr = (LAS float*)(F.lds + RING_OFF + F.wave * 16384);
    const int gw = F.vcu * NWAVES + F.wave, NGW = F.G * NWAVES;
    constexpr int I_IN = (D / 64) * (NCOL / 32), I_OA = (WA / 64) * (D / 32), I_OUT = (D / 64) * (D / 32), I_1 = (D / 64) * (FF / 32), I_2 = (FF / 64) * (D / 32), I_PB = 16 * 64;
    constexpr int NITEMS = I_IN + I_OA + I_OUT + I_1 + I_2 + I_PB;
    for (int it = gw; it < NITEMS; it += NGW) {
        int r = it;
        if (r < I_IN) { p0_transpose_item(a.in[1], D, NCOL, (bf16*)(ws + WS_WIN), scr, r, F.lane); continue; } r -= I_IN;
        if (r < I_OA) { p0_transpose_item(a.in[6], WA, D, (bf16*)(ws + WS_WOA), scr, r, F.lane); continue; } r -= I_OA;
        if (r < I_OUT) { p0_transpose_item(a.in[8], D, D, (bf16*)(ws + WS_WOUT), scr, r, F.lane); continue; } r -= I_OUT;
        if (r < I_1) { p0_transpose_item(a.in[11], D, FF, (bf16*)(ws + WS_W1), scr, r, F.lane); continue; } r -= I_1;
        if (r < I_2) { p0_transpose_item(a.in[13], FF, D, (bf16*)(ws + WS_W2), scr, r, F.lane); continue; } r -= I_2;
        p0_wpb_item(a.in[4], a.in[5], a.in[7], (bf16*)(ws + WS_WPB), r, F.lane);
    }
    const GAS f32x4* xs = (const GAS f32x4*)a.in[0]; GAS v4u* xd = (GAS v4u*)(ws + WS_XB);
    for (size_t i = (size_t)gw * 64 + F.lane; i < (size_t)M * D / 8; i += (size_t)NGW * 64) {
        const f32x4 v0 = xs[2 * i], v1 = xs[2 * i + 1];
        v4u o; o.x = pk2(v0.x, v0.y); o.y = pk2(v0.z, v0.w); o.z = pk2(v1.x, v1.y); o.w = pk2(v1.z, v1.w); xd[i] = o;
    }
}
__device__ __forceinline__ void pooled_phase(Frame& F, const bf16* P, bf16* PO) {
    const int gw = F.vcu * NWAVES + F.wave, NGW = F.G * NWAVES;
    const int w = 2 << (F.lane >> 4);
    for (int m = gw; m < M; m += NGW) {
        const int t = m & (SEQ - 1); const int cnt = (t + 1) < w ? (t + 1) : w;
        float s[8], cur[8];
#pragma unroll
        for (int i = 0; i < 8; ++i) s[i] = 0.f;
        const GAS v4u* src = (const GAS v4u*)(P + (size_t)m * 512) + F.lane;
#pragma unroll
        for (int j = 0; j < 16; ++j) {
            if (j < cnt) { const v4u v = src[-(long)j * 64];
                const float e[8] = {bflo(v.x), bfhi(v.x), bflo(v.y), bfhi(v.y), bflo(v.z), bfhi(v.z), bflo(v.w), bfhi(v.w)};
#pragma unroll
                for (int i = 0; i < 8; ++i) { s[i] += e[i]; if (j == 0) cur[i] = e[i]; } }
        }
        const float fc = (float)cnt;
        v4u o; o.x = pk2(s[0] / fc - cur[0], s[1] / fc - cur[1]); o.y = pk2(s[2] / fc - cur[2], s[3] / fc - cur[3]);
        o.z = pk2(s[4] / fc - cur[4], s[5] / fc - cur[5]); o.w = pk2(s[6] / fc - cur[6], s[7] / fc - cur[7]);
        *((GAS v4u*)(PO + (size_t)m * 512) + F.lane) = o;
    }
}
template <int MODE> __device__ __forceinline__ void ln_rows(Frame& F, float* X, const float* gam, const float* bet, bf16* OB, float* stats) {
    const int gw = F.vcu * NWAVES + F.wave, NGW = F.G * NWAVES;
    f32x4 gv[4], bv[4];
#pragma unroll
    for (int j = 0; j < 4; ++j) { gv[j] = ((const GAS f32x4*)gam)[F.lane + 64 * j]; bv[j] = ((const GAS f32x4*)bet)[F.lane + 64 * j]; }
    for (int m = gw; m < M; m += NGW) {
        GAS f32x4* xr = (GAS f32x4*)(X + (size_t)m * D) + F.lane;
        f32x4 v[4]; float s = 0.f;
#pragma unroll
        for (int j = 0; j < 4; ++j) { v[j] = xr[64 * j]; s += (v[j].x + v[j].y) + (v[j].z + v[j].w); }
        const float mean = wave_sum(s) * (1.f / D); float s2 = 0.f;
#pragma unroll
        for (int j = 0; j < 4; ++j) { v[j] = v[j] - mean; s2 += (v[j].x * v[j].x + v[j].y * v[j].y) + (v[j].z * v[j].z + v[j].w * v[j].w); }
        const float rstd = 1.f / sqrtf(wave_sum(s2) * (1.f / D) + LN_EPS);
        if (MODE == 0) {
            GAS unsigned long long* o8 = (GAS unsigned long long*)(OB + (size_t)m * D) + F.lane;
#pragma unroll
            for (int j = 0; j < 4; ++j) { const f32x4 o = v[j] * rstd * gv[j] + bv[j]; o8[64 * j] = (unsigned long long)pk2(o.x, o.y) | ((unsigned long long)pk2(o.z, o.w) << 32); }
            if (F.lane == 0) { stats[2 * (size_t)m] = mean; stats[2 * (size_t)m + 1] = rstd; }
        } else {
#pragma unroll
            for (int j = 0; j < 4; ++j) xr[64 * j] = v[j] * rstd * gv[j] + bv[j];
        }
    }
}
__device__ __forceinline__ int rel_bucket_dev(int n) {
    if (n < 16) return n;
    const int bd[15] = {19, 21, 24, 27, 31, 35, 40, 46, 52, 59, 67, 77, 87, 99, 113};
    int b = 16;
#pragma unroll
    for (int i = 0; i < 15; ++i) b += (n >= bd[i]) ? 1 : 0;
    return b;
}
__device__ __forceinline__ void attn_naive_phase(Frame& F, const bf16* Q, const bf16* K, const bf16* V, const float* ksum, const float* rel_table, bf16* ATT) {
    LAS float* lut = (LAS float*)(F.lds + RING_OFF);
    for (int i = F.tid; i < NH * 128; i += NWAVES * 64) { const int h = i >> 7, n = i & 127; lut[i] = rel_table[rel_bucket_dev(n) * NH + h] * LOG2E; }
    __syncthreads();
    const int gw = F.vcu * NWAVES + F.wave, NGW = F.G * NWAVES, lane = F.lane;
    for (int task = gw; task < M * NH; task += NGW) {
        const int m = task >> 3, h = task & 7, b = m >> 13, t = m & (SEQ - 1), ib = t >> 8;
        float q[64];
        { const GAS v4u* qp = (const GAS v4u*)(Q + (size_t)m * 512 + h * 64);
#pragma unroll
          for (int c = 0; c < 8; ++c) { const v4u v = qp[c]; q[8 * c] = bflo(v.x); q[8 * c + 1] = bfhi(v.x); q[8 * c + 2] = bflo(v.y); q[8 * c + 3] = bfhi(v.y); q[8 * c + 4] = bflo(v.z); q[8 * c + 5] = bfhi(v.z); q[8 * c + 6] = bflo(v.w); q[8 * c + 7] = bfhi(v.w); } }
        float g = -3.0e38f;
        if (lane < ib) { const GAS f32x4* kp = (const GAS f32x4*)(ksum + (size_t)(b * NBLK + lane) * 512 + h * 64); float a = 0.f;
#pragma unroll
            for (int c = 0; c < 16; ++c) { const f32x4 v = kp[c]; a += q[4 * c] * v.x + q[4 * c + 1] * v.y + q[4 * c + 2] * v.z + q[4 * c + 3] * v.w; }
            g = a; }
        int sel[4]; const int nsel = ib < 3 ? ib : 3;
#pragma unroll
        for (int s = 0; s < 3; ++s) {
            float bv = g; int bi = lane;
#pragma unroll
            for (int o = 1; o < 64; o <<= 1) { const float ov = __shfl_xor(bv, o); const int oi = __shfl_xor(bi, o); if (ov > bv || (ov == bv && oi < bi)) { bv = ov; bi = oi; } }
            sel[s] = bi; if (lane == bi) g = -3.0e38f;
        }
        sel[3] = ib;
        float sc[16];
#pragma unroll
        for (int s = 0; s < 4; ++s) {
            const bool valid = (s == 3) || (s < nsel);
            const int jb = (s == 3) ? ib : sel[s];
#pragma unroll
            for (int kk = 0; kk < 4; ++kk) {
                float v = -1.0e30f;
                if (valid) {
                    const int key = jb * BLK + kk * 64 + lane;
                    const GAS v4u* kp = (const GAS v4u*)(K + ((size_t)b * SEQ + key) * 512 + h * 64); float a = 0.f;
#pragma unroll
                    for (int c = 0; c < 8; ++c) { const v4u w = kp[c]; a += q[8 * c] * bflo(w.x) + q[8 * c + 1] * bfhi(w.x) + q[8 * c + 2] * bflo(w.y) + q[8 * c + 3] * bfhi(w.y) + q[8 * c + 4] * bflo(w.z) + q[8 * c + 5] * bfhi(w.z) + q[8 * c + 6] * bflo(w.w) + q[8 * c + 7] * bfhi(w.w); }
                    const int dist = t - key;
                    if (dist >= 0) v = a + lut[h * 128 + (dist < 127 ? dist : 127)];
                }
                sc[s * 4 + kk] = v;
            }
        }
        float mx = sc[0];
#pragma unroll
        for (int i = 1; i < 16; ++i) mx = fmaxf(mx, sc[i]);
        mx = wave_max(mx);
        float l = 0.f;
#pragma unroll
        for (int i = 0; i < 16; ++i) { sc[i] = __builtin_amdgcn_exp2f(sc[i] - mx); l += sc[i]; }
        l = wave_sum(l);
        float o = 0.f;
#pragma unroll
        for (int s = 0; s < 4; ++s) {
            const bool valid = (s == 3) || (s < nsel);
            if (valid) {
                const int jb = (s == 3) ? ib : sel[s];
#pragma unroll
                for (int kk = 0; kk < 4; ++kk) {
                    const bf16* vp = V + ((size_t)b * SEQ + jb * BLK + kk * 64) * 512 + h * 64 + lane;
                    const float pr = sc[s * 4 + kk];
                    for (int l2 = 0; l2 < 64; ++l2) { const float p = __shfl(pr, l2); o += p * __uint_as_float((unsigned)vp[(size_t)l2 * 512] << 16); }
                }
            }
        }
        ATT[(size_t)m * 512 + h * 64 + lane] = (bf16)f2bf(o / l);
    }
    __syncthreads();
}
__global__ void __launch_bounds__(NWAVES * 64, 2) moba_fwd(Args args) {
    const int ph_lo = args.ph_lo, ph_hi = args.ph_hi;
#define IN(k) (ph_lo <= (k) && (k) < ph_hi)
#define BOTH(k) (IN(k) && IN((k) + 1))
    extern __shared__ __attribute__((aligned(16))) unsigned char lds[];
    Frame F;
    F.lds = (LAS unsigned char*)lds;
    F.MISC = (volatile LAS unsigned*)(F.lds + MISC_OFF);
    F.tid = threadIdx.x; F.lane = F.tid & 63; F.wave = __builtin_amdgcn_readfirstlane(F.tid >> 6);
    F.G = gridDim.x; { const int bx = blockIdx.x; F.vcu = (F.G % 8 == 0) ? (bx % 8) * (F.G / 8) + bx / 8 : bx; }
    unsigned char* ws = args.ws;
    F.ctl = (gu32*)(ws + WS_CTL);
    for (int u = F.tid; u < (LDS_BYTES - LDSCTL_OFF) / 4; u += NWAVES * 64) ((LAS unsigned*)(F.lds + LDSCTL_OFF))[u] = 0u;
    __syncthreads();
    XcdBarrier bar; bar.bar = (unsigned*)(F.ctl + CW_BAR); bar.x = 0; bar.st = nullptr;
    if (ph_hi - ph_lo > 1) bar = xcd_barrier_post((unsigned*)(F.ctl + CW_BAR), F.MISC + 8);
#define GRID_BAR(k) do { if (BOTH(k)) xcd_barrier(bar); } while (0)
    bf16* const Win_t = (bf16*)(ws + WS_WIN); bf16* const Woa_t = (bf16*)(ws + WS_WOA); bf16* const Wpb_t = (bf16*)(ws + WS_WPB);
    bf16* const Wout_t = (bf16*)(ws + WS_WOUT); bf16* const W1_t = (bf16*)(ws + WS_W1); bf16* const W2_t = (bf16*)(ws + WS_W2);
    bf16* const XB = (bf16*)(ws + WS_XB); bf16* const QKVP = (bf16*)(ws + WS_QKVP); bf16* const GT = (bf16*)(ws + WS_G);
    bf16* const POOLED = (bf16*)(ws + WS_POOLED); bf16* const ATT = (bf16*)(ws + WS_ATT); bf16* const U = (bf16*)(ws + WS_U);
    float* const HPRE = (float*)(ws + WS_HPRE); bf16* const HB = (bf16*)(ws + WS_HB); bf16* const FB = (bf16*)(ws + WS_F);
    float* const KSUM = (float*)(ws + WS_KSUM); float* const STATS = (float*)(ws + WS_STATS);
    const bf16* Qb = QKVP; const bf16* Kb = QKVP + (size_t)M * 512; const bf16* Vb = QKVP + (size_t)2 * M * 512; const bf16* Pb = QKVP + (size_t)3 * M * 512;

    if (IN(0)) { p0_prologue(F, args); GRID_BAR(0); }
    if (IN(1)) { pg8::Gemm g{XB, Win_t, M, NCOL, D}; pg8::StaticOrder S; S.init(M, NCOL, F.G, (int)blockIdx.x);
      pg8::EpiProj E{QKVP, GT, args.in[2], KSUM, QSCALE};
      pg8::gemm_phase<pg8::EpiProj, pg8::StaticOrder, true, true>(F.lds + RING_OFF, g, S, E); GRID_BAR(1); }
    if (IN(2)) { pooled_phase(F, Pb, POOLED);
#if defined(EXP_NOATT)
      { const int gw = F.vcu * NWAVES + F.wave, NGW = F.G * NWAVES; for (size_t i = (size_t)gw * 64 + F.lane; i < (size_t)M * 512 / 8; i += (size_t)NGW * 64) ((GAS v4u*)ATT)[i] = (v4u){0u, 0u, 0u, 0u}; }
#else
      attn_naive_phase(F, Qb, Kb, Vb, KSUM, args.in[3], ATT);
#endif
 GRID_BAR(2); }
    if (IN(3)) { { pg8::Gemm g{POOLED, Wpb_t, M, D, WA}; pg8::StaticOrder S; S.init(M, D, F.G, (int)blockIdx.x);
      pg8::EpiBranch<false> E{U, GT};
      pg8::gemm_phase<pg8::EpiBranch<false>, pg8::StaticOrder, true, true>(F.lds + RING_OFF, g, S, E); }
    { pg8::Gemm g{ATT, Woa_t, M, D, WA}; pg8::StaticOrder S; S.init(M, D, F.G, (int)blockIdx.x);
      pg8::EpiBranch<true> E{U, GT};
      pg8::gemm_phase<pg8::EpiBranch<true>, pg8::StaticOrder, true, true>(F.lds + RING_OFF, g, S, E); }
    GRID_BAR(3); }
    if (IN(4)) { pg8::Gemm g{U, Wout_t, M, D, D}; pg8::StaticOrder S; S.init(M, D, F.G, (int)blockIdx.x);
      pg8::EpiMix E{args.in[0], HPRE, ALPHA};
      pg8::gemm_phase<pg8::EpiMix, pg8::StaticOrder, true, true>(F.lds + RING_OFF, g, S, E); GRID_BAR(4); }
    if (IN(5)) { ln_rows<0>(F, HPRE, args.in[9], args.in[10], HB, STATS); GRID_BAR(5); }
    if (IN(6)) { pg8::Gemm g{HB, W1_t, M, FF, D}; pg8::StaticOrder S; S.init(M, FF, F.G, (int)blockIdx.x);
      pg8::EpiFF1 E{FB, args.in[12]};
      pg8::gemm_phase<pg8::EpiFF1, pg8::StaticOrder, true, true>(F.lds + RING_OFF, g, S, E); GRID_BAR(6); }
    if (IN(7)) { pg8::Gemm g{FB, W2_t, M, D, FF}; pg8::StaticOrder S; S.init(M, D, F.G, (int)blockIdx.x);
      pg8::EpiFF2 E{HPRE, STATS, args.in[9], args.in[10], args.in[14], args.out, ALPHA};
      pg8::gemm_phase<pg8::EpiFF2, pg8::StaticOrder, true, true>(F.lds + RING_OFF, g, S, E); GRID_BAR(7); }
    if (IN(8)) ln_rows<1>(F, args.out, args.in[15], args.in[16], nullptr, nullptr);


#if defined(EXP_CHK0)
    if (ph_lo == 98) {
        const int gw = F.vcu * NWAVES + F.wave, NGW = F.G * NWAVES;
        for (int m = gw; m < M; m += NGW) for (int c = F.lane; c < 1024; c += 64) {
            float d = fabsf(bflo((unsigned)XB[(size_t)m * 1024 + c]) - args.in[0][(size_t)m * 1024 + c]);
            if (m < 4096) d = fmaxf(d, fabsf(bflo((unsigned)Win_t[(size_t)m * 1024 + c]) - args.in[1][(size_t)c * 4096 + m]));
            else if (m < 8192) d = fmaxf(d, fabsf(bflo((unsigned)W1_t[(size_t)(m - 4096) * 1024 + c]) - args.in[11][(size_t)c * 4096 + (m - 4096)]));
            else if (m < 9216) d = fmaxf(d, fmaxf(fmaxf(fabsf(bflo((unsigned)W2_t[(size_t)(m - 8192) * 4096 + c]) - args.in[13][(size_t)c * 1024 + (m - 8192)]), fabsf(bflo((unsigned)W2_t[(size_t)(m - 8192) * 4096 + 3072 + c]) - args.in[13][(size_t)(3072 + c) * 1024 + (m - 8192)])),
                                         fabsf(bflo((unsigned)Wout_t[(size_t)(m - 8192) * 1024 + c]) - args.in[8][(size_t)c * 1024 + (m - 8192)])));
            else if (m < 10240 && c < 512) d = fmaxf(d, fabsf(bflo((unsigned)Woa_t[(size_t)(m - 9216) * 512 + c]) - args.in[6][(size_t)c * 1024 + (m - 9216)]));
            args.out[(size_t)m * 1024 + c] = 1000.f * d;
        }
    }
#endif
#if defined(EXP_CHK1)
    if (ph_lo == 98) {
        const int gw = F.vcu * NWAVES + F.wave, NGW = F.G * NWAVES;
        for (size_t i = (size_t)gw * 64 + F.lane; i < (size_t)M * 1024; i += (size_t)NGW * 64) args.out[i] = 0.f;
        for (int task = gw; task < 537 * 64; task += NGW) {
            const int j = task >> 6, c = (task & 63) * 64 + F.lane, m = 61 * j + 7;
            const float* xr = args.in[0] + (size_t)m * 1024; const float* w = args.in[1] + c;
            float a = 0.f;
            for (int k = 0; k < 1024; ++k) a += xr[k] * w[(size_t)k * 4096];
            float st, ex;
            if (c < 512) { st = bflo((unsigned)Qb[(size_t)m * 512 + c]); ex = a * QSCALE; }
            else if (c < 1024) { st = bflo((unsigned)Kb[(size_t)m * 512 + c - 512]); ex = a; }
            else if (c < 1536) { st = bflo((unsigned)Vb[(size_t)m * 512 + c - 1024]); ex = a; }
            else if (c < 2048) { st = bflo((unsigned)Pb[(size_t)m * 512 + c - 1536]); ex = a; }
            else { st = bflo((unsigned)GT[(size_t)m * 2048 + c - 2048]); ex = 1.f / (1.f + expf(-(a + args.in[2][c - 2048]))); }
            const bool inc = (c >= EXP_CLO && c < EXP_CHI);
            args.out[(size_t)j * 4096 + c] = inc ? 1000.f * fabsf(st - ex) : 0.f;
        }
    }
#endif
#if defined(EXP_STOP)
    {
        const int gw = F.vcu * NWAVES + F.wave, NGW = F.G * NWAVES;
        if (ph_lo == 99) {
        for (int m = gw; m < M; m += NGW) {
            for (int c = F.lane; c < 1024; c += 64) {
                float v = 0.f;
#if EXP_STOP == 0
                v = bflo((unsigned)XB[(size_t)m * 1024 + c]); if (m < 4096) v += bflo((unsigned)Win_t[(size_t)m * 1024 + c]);
#elif EXP_STOP == 1
                v = bflo((unsigned)GT[(size_t)m * 2048 + c]) + bflo((unsigned)GT[(size_t)m * 2048 + 1024 + c]);
                if (c < 512) v += bflo((unsigned)Qb[(size_t)m * 512 + c]) + bflo((unsigned)Vb[(size_t)m * 512 + c]); else v += bflo((unsigned)Kb[(size_t)m * 512 + c - 512]) + bflo((unsigned)Pb[(size_t)m * 512 + c - 512]);
#elif EXP_STOP == 2
                v = bflo((unsigned)POOLED[(size_t)m * 512 + (c & 511)]);
#elif EXP_STOP == 3
                v = bflo((unsigned)U[(size_t)m * 1024 + c]);
#elif EXP_STOP == 4
                v = HPRE[(size_t)m * 1024 + c];
#elif EXP_STOP == 5
                v = bflo((unsigned)HB[(size_t)m * 1024 + c]);
#elif EXP_STOP == 6
                v = bflo((unsigned)FB[(size_t)m * 4096 + c]) + bflo((unsigned)FB[(size_t)m * 4096 + 1024 + c]) + bflo((unsigned)FB[(size_t)m * 4096 + 2048 + c]) + bflo((unsigned)FB[(size_t)m * 4096 + 3072 + c]);
#endif
                args.out[(size_t)m * 1024 + c] = v;
            }
        }
        }
    }
#endif
#undef IN
#undef BOTH
}

extern "C" void kernel_launch(void* const* d_in, const int* in_sizes, int n_in, void* d_out, int out_size, void* d_ws, size_t ws_size, hipStream_t stream) {
    static int grid = 0;
    if (grid == 0) {
        if (n_in != 17 || in_sizes[0] != M * D || out_size != M * D || ws_size < WS_END) { fprintf(stderr, "kernel_launch: unexpected shapes (n_in %d, in0 %d, out %d, ws %zu); nothing launched\n", n_in, n_in > 0 ? in_sizes[0] : -1, out_size, ws_size); grid = -1; return; }
        int dev = 0, cus = 0, per_cu = 0;
        if (hipGetDevice(&dev) != hipSuccess || hipDeviceGetAttribute(&cus, hipDeviceAttributeMultiprocessorCount, dev) != hipSuccess) { grid = -1; return; }
        if (hipFuncSetAttribute((const void*)moba_fwd, hipFuncAttributeMaxDynamicSharedMemorySize, LDS_BYTES) != hipSuccess) { fprintf(stderr, "kernel_launch: hipFuncSetAttribute failed\n"); grid = -1; return; }
        if (hipOccupancyMaxActiveBlocksPerMultiprocessor(&per_cu, (const void*)moba_fwd, NWAVES * 64, LDS_BYTES) != hipSuccess || per_cu < 1) { fprintf(stderr, "kernel_launch: occupancy query says %d blocks per CU\n", per_cu); }
        (void)hipGetLastError();
        grid = cus;
    }
    if (grid < 0) return;
    (void)hipMemsetAsync((char*)d_ws + WS_CTL, 0, CTL_ZERO_BYTES, stream);
    Args a{};
    for (int i = 0; i < 17; ++i) a.in[i] = (const float*)d_in[i];
    a.out = (float*)d_out; a.ws = (unsigned char*)d_ws;
#if N_LAUNCHES == 1
    a.ph_lo = 0; a.ph_hi = 9;
    hipLaunchKernelGGL(moba_fwd, dim3(grid), dim3(NWAVES * 64), LDS_BYTES, stream, a);
#else
#if defined(EXP_STOP)
    for (int p = 0; p <= EXP_STOP; ++p) { a.ph_lo = p; a.ph_hi = p + 1; hipLaunchKernelGGL(moba_fwd, dim3(grid), dim3(NWAVES * 64), LDS_BYTES, stream, a); }
#if defined(EXP_CHK1) || defined(EXP_CHK0)
    a.ph_lo = 98; a.ph_hi = 99; hipLaunchKernelGGL(moba_fwd, dim3(grid), dim3(NWAVES * 64), LDS_BYTES, stream, a);
#else
    a.ph_lo = 99; a.ph_hi = 100; hipLaunchKernelGGL(moba_fwd, dim3(grid), dim3(NWAVES * 64), LDS_BYTES, stream, a);
#endif
    if (0)
#endif
    for (int p = 0; p < 9; ++p) { a.ph_lo = p; a.ph_hi = p + 1; hipLaunchKernelGGL(moba_fwd, dim3(grid), dim3(NWAVES * 64), LDS_BYTES, stream, a); }
#endif
}
```

```cpp
#include <hip/hip_runtime.h>
#include <cstdio>
#include <cstdint>
constexpr int MROWS = 32768;
namespace pg8 {
#define PG8_LAS __attribute__((address_space(3)))
typedef unsigned short bf16_t;
typedef short bf16x8 __attribute__((ext_vector_type(8)));
typedef float f32x4 __attribute__((ext_vector_type(4)));
typedef unsigned u32x4 __attribute__((ext_vector_type(4)));
constexpr int BM = 256, BK = 64, HALF = 128, HTB = HALF * BK * 2  , STAGE_BYTES = 8 * HTB, NXCD = 8, WGM = 8;

__host__ __device__ __forceinline__ int lds_byte(int r, int c) { const int st = (r >> 4) * 2 + (c >> 5), rr = r & 15, cc = c & 31, ob = rr * 64 + cc * 2; return st * 1024 + (ob ^ (((ob >> 9) & 1) << 5)); }
__host__ __device__ __forceinline__ void stage_rc(int b, int& R, int& C) { const int st = b / 1024, sb = b % 1024, swz = sb ^ (((sb >> 9) & 1) << 5); R = (st >> 1) * 16 + swz / 64; C = (st & 1) * 32 + (swz % 64) / 2; }
__host__ __device__ __forceinline__ int perm32(int rho) { const int n = rho >> 4, i = rho & 15; return 8 * (i >> 2) + 4 * n + (i & 3); }

struct Unit { int pm, pn; };
struct Gemm { const bf16_t* A; const bf16_t* Bt; int M, N, K; };

struct StaticOrder {
    int nM, nN, nwg, G, c;
    __host__ __device__ void init(int M, int N, int G_, int c_) { nM = M / BM; nN = N / BM; nwg = nM * nN; G = G_; c = c_; }
    __host__ __device__ bool next(int i, Unit& u) const {
        const long L = (long)i * G + c; if (L >= nwg) return false;
        int wgid = (int)L; { const int q = nwg / NXCD, r = nwg % NXCD, xcd = wgid % NXCD, off = wgid / NXCD; wgid = (xcd < r ? xcd * (q + 1) : r * (q + 1) + (xcd - r) * q) + off; }
        const int nig = WGM * nN, gid = wgid / nig, fm = gid * WGM, gsz = (nM - fm) < WGM ? (nM - fm) : WGM;
        u.pm = fm + ((wgid % nig) % gsz); u.pn = (wgid % nig) / gsz; return true;
    }
    __device__ __forceinline__ void a_ready(const Unit&) const {}
    __device__ __forceinline__ void done(const Unit&) const {}
};

typedef float f32x2_t __attribute__((ext_vector_type(2))); typedef __bf16 bf16x2_t __attribute__((ext_vector_type(2)));
__device__ __forceinline__ unsigned cvt_pk_bf16(float lo, float hi) { f32x2_t v = {lo, hi}; bf16x2_t b = __builtin_convertvector(v, bf16x2_t); return __builtin_bit_cast(unsigned, b); }
__device__ __forceinline__ float bf_lo(unsigned w) { return __uint_as_float(w << 16); }
__device__ __forceinline__ float bf_hi(unsigned w) { return __uint_as_float(w & 0xffff0000u); }
__device__ __forceinline__ float sigmoidf_fast(float x) { return __builtin_amdgcn_rcpf(1.0f + __builtin_amdgcn_exp2f(-1.4426950408889634f * x)); }
__device__ __forceinline__ u32x4 pack8(const f32x4 v0, const f32x4 v1) { u32x4 w; w.x = cvt_pk_bf16(v0[0], v0[1]); w.y = cvt_pk_bf16(v0[2], v0[3]); w.z = cvt_pk_bf16(v1[0], v1[1]); w.w = cvt_pk_bf16(v1[2], v1[3]); return w; }

struct EpiProj {
    static constexpr bool PERM = true, AFTER_DRAIN = false;
    bf16_t* QKVP; bf16_t* G; const float* bgate; float* ksum; float qscale;
    __device__ __forceinline__ void operator()(const f32x4 (&acc)[2][2][4][2], const Unit& u, int wr, int wc, int fr, int fq) const {
        const int row0 = u.pm * BM + wr * 64 + fr;
        if (u.pn < 8) {
            const int t = u.pn >> 1;
            bf16_t* base = QKVP + (size_t)t * ((size_t)MROWS * 512);
            const int col0 = (u.pn & 1) * 256 + wc * 32 + 8 * fq;
            const float sc = (t == 0) ? qscale : 1.f;
#pragma unroll
            for (int ai = 0; ai < 2; ++ai)
#pragma unroll
                for (int m = 0; m < 4; ++m) { bf16_t* rowp = base + (size_t)(row0 + ai * HALF + m * 16) * 512 + col0;
#pragma unroll
                    for (int bj = 0; bj < 2; ++bj) *(u32x4*)(rowp + bj * HALF) = pack8(acc[ai][bj][m][0] * sc, acc[ai][bj][m][1] * sc); }
            if (t == 1) {
#pragma unroll
                for (int bj = 0; bj < 2; ++bj)
#pragma unroll
                    for (int n = 0; n < 2; ++n) { f32x4 s = (f32x4){0.f, 0.f, 0.f, 0.f};
#pragma unroll
                        for (int ai = 0; ai < 2; ++ai)
#pragma unroll
                            for (int m = 0; m < 4; ++m) s += acc[ai][bj][m][n];
#pragma unroll
                        for (int e = 0; e < 4; ++e) { float v = s[e]; v += __shfl_xor(v, 1); v += __shfl_xor(v, 2); v += __shfl_xor(v, 4); v += __shfl_xor(v, 8);
                            if (fr == 0) unsafeAtomicAdd(ksum + (size_t)u.pm * 512 + col0 + bj * HALF + 4 * n + e, v); } }
            }
        } else {
            const int gcol0 = (u.pn - 8) * 256 + wc * 32 + 8 * fq;
            f32x4 bv[2][2];
#pragma unroll
            for (int bj = 0; bj < 2; ++bj)
#pragma unroll
                for (int n = 0; n < 2; ++n) bv[bj][n] = *(const f32x4*)(bgate + gcol0 + bj * HALF + 4 * n);
#pragma unroll
            for (int ai = 0; ai < 2; ++ai)
#pragma unroll
                for (int m = 0; m < 4; ++m) { bf16_t* rowp = G + (size_t)(row0 + ai * HALF + m * 16) * 2048 + gcol0;
#pragma unroll
                    for (int bj = 0; bj < 2; ++bj) { f32x4 v0 = acc[ai][bj][m][0] + bv[bj][0], v1 = acc[ai][bj][m][1] + bv[bj][1];
#pragma unroll
                        for (int e = 0; e < 4; ++e) { v0[e] = sigmoidf_fast(v0[e]); v1[e] = sigmoidf_fast(v1[e]); }
                        *(u32x4*)(rowp + bj * HALF) = pack8(v0, v1); } }
        }
    }
};
template <bool ADD> struct EpiBranch {
    static constexpr bool PERM = true, AFTER_DRAIN = false;
    bf16_t* U; const bf16_t* G;
    __device__ __forceinline__ void operator()(const f32x4 (&acc)[2][2][4][2], const Unit& u, int wr, int wc, int fr, int fq) const {
        const int row0 = u.pm * BM + wr * 64 + fr, col0 = u.pn * BM + wc * 32 + 8 * fq;
#pragma unroll
        for (int ai = 0; ai < 2; ++ai)
#pragma unroll
            for (int m = 0; m < 4; ++m) { const size_t r = (size_t)(row0 + ai * HALF + m * 16);
#pragma unroll
                for (int bj = 0; bj < 2; ++bj) { const int c = col0 + bj * HALF;
                    const u32x4 g = *(const u32x4*)(G + r * 2048 + (ADD ? 0 : 1024) + c);
                    f32x4 v0 = acc[ai][bj][m][0], v1 = acc[ai][bj][m][1];
                    v0[0] *= bf_lo(g.x); v0[1] *= bf_hi(g.x); v0[2] *= bf_lo(g.y); v0[3] *= bf_hi(g.y);
                    v1[0] *= bf_lo(g.z); v1[1] *= bf_hi(g.z); v1[2] *= bf_lo(g.w); v1[3] *= bf_hi(g.w);
                    if (ADD) { const u32x4 o = *(const u32x4*)(U + r * 1024 + c);
                        v0[0] += bf_lo(o.x); v0[1] += bf_hi(o.x); v0[2] += bf_lo(o.y); v0[3] += bf_hi(o.y);
                        v1[0] += bf_lo(o.z); v1[1] += bf_hi(o.z); v1[2] += bf_lo(o.w); v1[3] += bf_hi(o.w); }
                    *(u32x4*)(U + r * 1024 + c) = pack8(v0, v1); } }
    }
};
struct EpiMix {
    static constexpr bool PERM = false, AFTER_DRAIN = false;
    const float* X; float* H; float alpha;
    __device__ __forceinline__ void operator()(const f32x4 (&acc)[2][2][4][2], const Unit& u, int wr, int wc, int fr, int fq) const {
        const int row0 = u.pm * BM + wr * 64 + fr, col0 = u.pn * BM + wc * 32 + 4 * fq;
#pragma unroll
        for (int ai = 0; ai < 2; ++ai)
#pragma unroll
            for (int m = 0; m < 4; ++m) { const size_t off = (size_t)(row0 + ai * HALF + m * 16) * 1024 + col0;
#pragma unroll
                for (int bj = 0; bj < 2; ++bj)
#pragma unroll
                    for (int n = 0; n < 2; ++n) { const f32x4 xv = *(const f32x4*)(X + off + bj * HALF + n * 16); *(f32x4*)(H + off + bj * HALF + n * 16) = xv * alpha + acc[ai][bj][m][n]; } }
    }
};
struct EpiFF1 {
    static constexpr bool PERM = true, AFTER_DRAIN = false;
    bf16_t* F; const float* bias;
    __device__ __forceinline__ void operator()(const f32x4 (&acc)[2][2][4][2], const Unit& u, int wr, int wc, int fr, int fq) const {
        const int row0 = u.pm * BM + wr * 64 + fr, col0 = u.pn * BM + wc * 32 + 8 * fq;
        f32x4 bv[2][2];
#pragma unroll
        for (int bj = 0; bj < 2; ++bj)
#pragma unroll
            for (int n = 0; n < 2; ++n) bv[bj][n] = *(const f32x4*)(bias + col0 + bj * HALF + 4 * n);
#pragma unroll
        for (int ai = 0; ai < 2; ++ai)
#pragma unroll
            for (int m = 0; m < 4; ++m) { bf16_t* rowp = F + (size_t)(row0 + ai * HALF + m * 16) * 4096 + col0;
#pragma unroll
                for (int bj = 0; bj < 2; ++bj) { f32x4 v0 = acc[ai][bj][m][0] + bv[bj][0], v1 = acc[ai][bj][m][1] + bv[bj][1];
#pragma unroll
                    for (int e = 0; e < 4; ++e) { const float a = fmaxf(v0[e], 0.f), b = fmaxf(v1[e], 0.f); v0[e] = a * a; v1[e] = b * b; }
                    *(u32x4*)(rowp + bj * HALF) = pack8(v0, v1); } }
    }
};
struct EpiFF2 {
    static constexpr bool PERM = false, AFTER_DRAIN = false;
    const float* HPRE; const float* stats; const float* g1; const float* bt1; const float* b2; float* OUT; float alpha;
    __device__ __forceinline__ void operator()(const f32x4 (&acc)[2][2][4][2], const Unit& u, int wr, int wc, int fr, int fq) const {
        typedef float f32x2v __attribute__((ext_vector_type(2)));
        const int row0 = u.pm * BM + wr * 64 + fr, col0 = u.pn * BM + wc * 32 + 4 * fq;
        f32x4 c1[2][2], c0[2][2];
#pragma unroll
        for (int bj = 0; bj < 2; ++bj)
#pragma unroll
            for (int n = 0; n < 2; ++n) { const int c = col0 + bj * HALF + n * 16; c1[bj][n] = *(const f32x4*)(g1 + c) * alpha; c0[bj][n] = *(const f32x4*)(bt1 + c) * alpha + *(const f32x4*)(b2 + c); }
#pragma unroll
        for (int ai = 0; ai < 2; ++ai)
#pragma unroll
            for (int m = 0; m < 4; ++m) { const size_t r = (size_t)(row0 + ai * HALF + m * 16); const f32x2v st = *(const f32x2v*)(stats + 2 * r); const size_t off = r * 1024 + col0;
#pragma unroll
                for (int bj = 0; bj < 2; ++bj)
#pragma unroll
                    for (int n = 0; n < 2; ++n) { const f32x4 hp = *(const f32x4*)(HPRE + off + bj * HALF + n * 16);
                        *(f32x4*)(OUT + off + bj * HALF + n * 16) = acc[ai][bj][m][n] + c0[bj][n] + ((hp - st.x) * st.y) * c1[bj][n]; } }
    }
};
template <class Epi, class Sched, bool ALIGN_EPI = false, bool SP2 = false>
__device__ __forceinline__ void gemm_phase(PG8_LAS unsigned char* lds, const Gemm g, const Sched& S, const Epi& E) {
    const int tid = threadIdx.x, wid = __builtin_amdgcn_readfirstlane(tid >> 6), lane = tid & 63, wr = wid >> 2, wc = wid & 3, fr = lane & 15, fq = lane >> 4;
    const int K = g.K, nt = K / BK;
    unsigned voffA[2], voffB[2];
#pragma unroll
    for (int i = 0; i < 2; ++i) { int R, C; stage_rc(tid * 16 + i * 8192, R, C); const int Rb = Epi::PERM ? ((R & ~31) + perm32(R & 31)) : R;
        voffA[i] = (unsigned)(R * K + C) * 2u; voffB[i] = (unsigned)(Rb * K + C) * 2u; }
    const size_t kstep = (size_t)(BK * 2);
    const size_t hstep = (size_t)HALF * K * 2;
    const size_t tstep = 2 * hstep;
    const unsigned ldsw = (unsigned)wid * 1024u;
    const int aoff = lds_byte(wr * 64 + fr, fq * 8), boff = lds_byte(wc * 32 + fr, fq * 8);
#define PG8_SA(b, h) (((b) * 2 + (h)) * HTB)
#define PG8_SB(b, h) ((4 + (b) * 2 + (h)) * HTB)
#define PG8_STAGE(bufoff, gbase, voff) do { _Pragma("unroll") for (int _i = 0; _i < 2; ++_i) \
        __builtin_amdgcn_global_load_lds((const unsigned*)((const char*)(gbase) + (voff)[_i]), (PG8_LAS unsigned*)(lds + (bufoff) + ldsw + _i * 8192), 16, 0, 0); } while (0)
#define PG8_LDA(dst, b, h) do { _Pragma("unroll") for (int m = 0; m < 4; ++m) _Pragma("unroll") for (int k = 0; k < 2; ++k) dst[m][k] = *(const PG8_LAS bf16x8*)(lds + PG8_SA(b, h) + aoff + m * 2048 + k * 1024); } while (0)
#define PG8_LDB(dst, b, h) do { _Pragma("unroll") for (int n = 0; n < 2; ++n) _Pragma("unroll") for (int k = 0; k < 2; ++k) dst[n][k] = *(const PG8_LAS bf16x8*)(lds + PG8_SB(b, h) + boff + n * 2048 + k * 1024); } while (0)
#define PG8_MMA(ai, bj, At, Bt) do { __builtin_amdgcn_s_setprio(1); _Pragma("unroll") for (int m = 0; m < 4; ++m) _Pragma("unroll") for (int n = 0; n < 2; ++n) _Pragma("unroll") for (int k = 0; k < 2; ++k) \
        acc[ai][bj][m][n] = __builtin_amdgcn_mfma_f32_16x16x32_bf16(Bt[n][k], At[m][k], acc[ai][bj][m][n], 0, 0, 0); __builtin_amdgcn_s_setprio(0); } while (0)
#define PG8_WAIT_V(n) asm volatile("s_waitcnt vmcnt(" #n ")" ::: "memory")
#define PG8_WAIT_L(n) asm volatile("s_waitcnt lgkmcnt(" #n ")" ::: "memory")
#define PG8_BAR __builtin_amdgcn_s_barrier()
#define PG8_SCHED __builtin_amdgcn_sched_barrier(0)
    Unit cur, nxt; int ui = 0;
    if (!S.next(0, cur)) return;
    f32x4 acc[2][2][4][2];
#pragma unroll
    for (int a = 0; a < 2; ++a)
#pragma unroll
        for (int b = 0; b < 2; ++b)
#pragma unroll
            for (int m = 0; m < 4; ++m)
#pragma unroll
                for (int n = 0; n < 2; ++n) acc[a][b][m][n] = (f32x4){0.f, 0.f, 0.f, 0.f};
    bf16x8 At[4][2], B0[2][2], B1[2][2];
    const char* cA = (const char*)g.A + (size_t)cur.pm * tstep; const char* cB = (const char*)g.Bt + (size_t)cur.pn * tstep;
    S.a_ready(cur);
    if constexpr (SP2) {
        PG8_STAGE(PG8_SB(0, 0), cB, voffB); PG8_STAGE(PG8_SB(0, 1), cB + hstep, voffB); PG8_STAGE(PG8_SA(0, 0), cA, voffA); PG8_STAGE(PG8_SA(0, 1), cA + hstep, voffA);
        if (wr == 1) PG8_BAR;
        PG8_WAIT_V(2); PG8_BAR;
        PG8_STAGE(PG8_SB(1, 0), cB + kstep, voffB); PG8_STAGE(PG8_SA(1, 0), cA + kstep, voffA); PG8_STAGE(PG8_SB(1, 1), cB + hstep + kstep, voffB);
        PG8_WAIT_V(6); PG8_BAR;
    } else {
        PG8_STAGE(PG8_SB(0, 0), cB, voffB); PG8_STAGE(PG8_SA(0, 0), cA, voffA); PG8_STAGE(PG8_SB(0, 1), cB + hstep, voffB); PG8_STAGE(PG8_SA(0, 1), cA + hstep, voffA);
        if (wr == 1) PG8_BAR;
        PG8_WAIT_V(4); PG8_BAR;
        PG8_STAGE(PG8_SB(1, 0), cB + kstep, voffB); PG8_STAGE(PG8_SA(1, 0), cA + kstep, voffA); PG8_STAGE(PG8_SB(1, 1), cB + hstep + kstep, voffB);
        PG8_WAIT_V(6); PG8_BAR;
    }
    for (;;) {
        const bool has_next = S.next(ui + 1, nxt);
        const char* nA = has_next ? (const char*)g.A + (size_t)nxt.pm * tstep : cA; const char* nB = has_next ? (const char*)g.Bt + (size_t)nxt.pn * tstep : cB;
        for (int t = 0; t < nt; t += 2) {
            const bool last = (t == nt - 2);
            const char* a1 = cA + (size_t)(t + 1) * kstep;
            const char* a2 = last ? nA : cA + (size_t)(t + 2) * kstep; const char* b2 = last ? nB : cB + (size_t)(t + 2) * kstep;
            const char* a3 = a2 + kstep; const char* b3 = b2 + kstep;
            if (last && has_next) S.a_ready(nxt);
            if constexpr (SP2) {
            PG8_LDB(B0, 0, 0); PG8_LDB(B1, 0, 1); PG8_SCHED; PG8_LDA(At, 0, 0); PG8_STAGE(PG8_SA(1, 1), a1 + hstep, voffA);
            PG8_WAIT_V(8); PG8_WAIT_L(0); PG8_BAR; PG8_MMA(0, 0, At, B0); PG8_MMA(0, 1, At, B1); PG8_BAR; PG8_SCHED;
            PG8_LDA(At, 0, 1); PG8_STAGE(PG8_SB(0, 0), b2, voffB); PG8_STAGE(PG8_SB(0, 1), b2 + hstep, voffB); PG8_STAGE(PG8_SA(0, 0), a2, voffA);
            PG8_WAIT_V(8); PG8_WAIT_L(0); PG8_BAR; PG8_MMA(1, 0, At, B0); PG8_MMA(1, 1, At, B1); PG8_BAR; PG8_SCHED;
            PG8_LDB(B0, 1, 0); PG8_LDB(B1, 1, 1); PG8_SCHED; PG8_LDA(At, 1, 0); PG8_STAGE(PG8_SA(0, 1), a2 + hstep, voffA);
            PG8_WAIT_V(8); PG8_WAIT_L(0); PG8_BAR; PG8_MMA(0, 0, At, B0); PG8_MMA(0, 1, At, B1); PG8_BAR; PG8_SCHED;
            PG8_LDA(At, 1, 1); PG8_STAGE(PG8_SB(1, 0), b3, voffB); PG8_STAGE(PG8_SB(1, 1), b3 + hstep, voffB); PG8_STAGE(PG8_SA(1, 0), a3, voffA);
            PG8_WAIT_V(8); PG8_WAIT_L(0); PG8_BAR; PG8_MMA(1, 0, At, B0); PG8_MMA(1, 1, At, B1); PG8_BAR; PG8_SCHED;
            } else {
            PG8_LDB(B0, 0, 0); PG8_SCHED; PG8_LDA(At, 0, 0); PG8_STAGE(PG8_SA(1, 1), a1 + hstep, voffA);
            PG8_WAIT_L(8); PG8_BAR; PG8_WAIT_L(0); PG8_MMA(0, 0, At, B0); PG8_BAR; PG8_SCHED;
            PG8_LDB(B1, 0, 1); PG8_STAGE(PG8_SB(0, 0), b2, voffB);
            PG8_BAR; PG8_WAIT_L(0); PG8_MMA(0, 1, At, B1); PG8_BAR;
            PG8_LDA(At, 0, 1); PG8_STAGE(PG8_SA(0, 0), a2, voffA);
            PG8_BAR; PG8_WAIT_L(0); PG8_MMA(1, 0, At, B0); PG8_BAR; PG8_SCHED;
            PG8_STAGE(PG8_SB(0, 1), b2 + hstep, voffB);
            PG8_WAIT_V(6); PG8_BAR; PG8_MMA(1, 1, At, B1); PG8_BAR;
            PG8_LDB(B0, 1, 0); PG8_SCHED; PG8_LDA(At, 1, 0); PG8_STAGE(PG8_SA(0, 1), a2 + hstep, voffA);
            PG8_WAIT_L(8); PG8_BAR; PG8_WAIT_L(0); PG8_MMA(0, 0, At, B0); PG8_BAR; PG8_SCHED;
            PG8_LDB(B1, 1, 1); PG8_STAGE(PG8_SB(1, 0), b3, voffB);
            PG8_BAR; PG8_WAIT_L(0); PG8_MMA(0, 1, At, B1); PG8_BAR;
            PG8_LDA(At, 1, 1); PG8_STAGE(PG8_SA(1, 0), a3, voffA);
            PG8_BAR; PG8_WAIT_L(0); PG8_MMA(1, 0, At, B0); PG8_BAR; PG8_SCHED;
            PG8_STAGE(PG8_SB(1, 1), b3 + hstep, voffB);
            PG8_WAIT_V(6); PG8_BAR; PG8_MMA(1, 1, At, B1); PG8_BAR;
            }
        }
        if constexpr (ALIGN_EPI) { if (wr == 0) PG8_BAR; }
        if constexpr (!Epi::AFTER_DRAIN) { E(acc, cur, wr, wc, fr, fq); S.done(cur); }
        if (!has_next) break;
#pragma unroll
        for (int a = 0; a < 2; ++a)
#pragma unroll
            for (int b = 0; b < 2; ++b)
#pragma unroll
                for (int m = 0; m < 4; ++m)
#pragma unroll
                    for (int n = 0; n < 2; ++n) acc[a][b][m][n] = (f32x4){0.f, 0.f, 0.f, 0.f};
        cur = nxt; cA = nA; cB = nB; ++ui;
        if constexpr (ALIGN_EPI) { if (wr == 1) PG8_BAR; }
    }
    PG8_WAIT_V(0);
    if constexpr (!ALIGN_EPI) { if (wr == 0) PG8_BAR; }
    PG8_BAR;
    if constexpr (Epi::AFTER_DRAIN) { E.fused(acc, cur, wr, wc, fr, fq, lds, wid, lane); S.done(cur); }
#undef PG8_SA
#undef PG8_SB
#undef PG8_STAGE
#undef PG8_LDA
#undef PG8_LDB
#undef PG8_MMA
#undef PG8_WAIT_V
#undef PG8_WAIT_L
#undef PG8_BAR
#undef PG8_SCHED
}
}
constexpr int NWAVES = 8;
constexpr int SEQ = 8192, NB = 4, D = 1024, NH = 8, HD = 64, WA = 512, FF = 4096, NCOL = 4096, BLK = 256, NBLK = SEQ / BLK;
constexpr int M = MROWS;
constexpr float LN_EPS = 1e-5f;
constexpr float ALPHA = 1.189207115002721f;
constexpr float LOG2E = 1.4426950408889634f;
constexpr float QSCALE = 0.125f * LOG2E;
constexpr size_t MiB = 1u << 20;
constexpr size_t WS_CTL = 0, CTL_ZERO_BYTES = 1 * MiB;
constexpr size_t WS_KSUM = 512 * 1024;
constexpr size_t WS_STATS = 1 * MiB;
constexpr size_t WS_WIN = 4 * MiB, WS_WOA = 12 * MiB, WS_WPB = 13 * MiB, WS_WOUT = 14 * MiB, WS_W1 = 16 * MiB, WS_W2 = 24 * MiB;
constexpr size_t WS_XB = 32 * MiB;
constexpr size_t WS_QKVP = 96 * MiB;
constexpr size_t WS_G = 224 * MiB;
constexpr size_t WS_POOLED = 352 * MiB, WS_ATT = 384 * MiB, WS_U = 416 * MiB;
constexpr size_t WS_HPRE = 32 * MiB;
constexpr size_t WS_HB = 160 * MiB;
constexpr size_t WS_F = 224 * MiB;
constexpr size_t WS_END = 480 * MiB;
constexpr int CW_BAR = 4096;
constexpr int RING_OFF = 0, RING_BYTES = 131072;
constexpr int LDSCTL_OFF = RING_BYTES, MISC_OFF = LDSCTL_OFF + 320;
constexpr int LDS_BYTES = 147456;

#define GAS __attribute__((address_space(1)))
#define LAS __attribute__((address_space(3)))
typedef unsigned short bf16;
typedef unsigned v4u __attribute__((ext_vector_type(4)));
typedef float f32x4 __attribute__((ext_vector_type(4)));
typedef GAS unsigned gu32;
#define LDS_WAIT() asm volatile("s_waitcnt lgkmcnt(0)" ::: "memory")
#define VM_WAIT() asm volatile("s_waitcnt vmcnt(0)" ::: "memory")
__device__ __forceinline__ unsigned f2bf(float f) { unsigned u = __builtin_bit_cast(unsigned, f); return (u + 0x7fffu + ((u >> 16) & 1u)) >> 16; }
__device__ __forceinline__ unsigned pk2(float lo, float hi) { return f2bf(lo) | (f2bf(hi) << 16); }
__device__ __forceinline__ float bflo(unsigned w) { return __uint_as_float(w << 16); }
__device__ __forceinline__ float bfhi(unsigned w) { return __uint_as_float(w & 0xffff0000u); }
#define XB_TMO      128
#define XB_XCNT(j)  (256  + 64 * (j))
#define XB_XSUB(j)  (1280 + 64 * (j))
#define XB_XGEN(j)  (2304 + 64 * (j))
#define XB_TOP      3328
#define XB_TOPGEN   3392
#define XCD_BAR_WORDS 3456
#define XB_SPIN_CAP (1u << 24)

__device__ __forceinline__ unsigned xb_ld(unsigned* p)              { return __hip_atomic_load(p, __ATOMIC_RELAXED, __HIP_MEMORY_SCOPE_AGENT); }
__device__ __forceinline__ unsigned xb_add(unsigned* p, unsigned v) { return __hip_atomic_fetch_add(p, v, __ATOMIC_RELAXED, __HIP_MEMORY_SCOPE_AGENT); }
__device__ __forceinline__ unsigned xb_xcc_id() { return (unsigned)__builtin_amdgcn_s_getreg((3 << 11) | 20) & 0xFu; }
#define XB_SPIN(cond, bar) do { unsigned _sp = 0; while (cond) { __builtin_amdgcn_s_sleep(1); \
    if ((++_sp & 255u) == 0u) { if (xb_ld(&(bar)[XB_TMO])) break; if (_sp > XB_SPIN_CAP) { atomicAdd(&(bar)[XB_TMO], 1u); break; } } } } while (0)

struct XcdBarrier {
    unsigned* bar; unsigned x;
    volatile LAS unsigned* st;
};

__device__ __forceinline__ XcdBarrier xcd_barrier_post(unsigned* bar, volatile LAS unsigned* st) {
    XcdBarrier b; b.bar = bar; b.x = xb_xcc_id(); b.st = st;
    if (threadIdx.x == 0) (void)xb_add(&bar[XB_XCNT(b.x)], 1u);
    return b;
}
__device__ __forceinline__ void xcd_barrier_complete(unsigned* bar, unsigned x, unsigned& nloc, unsigned& nx) {
    const unsigned G = gridDim.x * gridDim.y * gridDim.z;
    unsigned sum, cnt, mine, sp = 0u;
    for (;;) {
        sum = 0u; cnt = 0u; mine = 0u;
#pragma unroll
        for (unsigned j = 0; j < 16; ++j) { const unsigned c = xb_ld(&bar[XB_XCNT(j)]); sum += c; cnt += (c > 0u) ? 1u : 0u; mine = (j == x) ? c : mine; }
        if (sum == G) break;
        __builtin_amdgcn_s_sleep(1);
        if ((++sp & 255u) == 0u) { if (xb_ld(&bar[XB_TMO])) break; if (sp > XB_SPIN_CAP) { atomicAdd(&bar[XB_TMO], 1u); break; } }
    }
    nloc = mine > 0u ? mine : 1u; nx = cnt > 0u ? cnt : 1u;
}

__device__ __forceinline__ void xcd_barrier(const XcdBarrier& b) {
    asm volatile("s_waitcnt vmcnt(0)" ::: "memory");
    __syncthreads();
    if (threadIdx.x == 0) {
        unsigned* bar = b.bar;
        __builtin_amdgcn_s_waitcnt(0);
        unsigned nloc = b.st[0], nx = b.st[1];
        if (nloc == 0u) { xcd_barrier_complete(bar, b.x, nloc, nx); b.st[0] = nloc; b.st[1] = nx; }
        const unsigned old = xb_add(&bar[XB_XSUB(b.x)], 1u);
        const unsigned gen = old / nloc;
        if (old + 1u == (gen + 1u) * nloc) {
            __builtin_amdgcn_fence(__ATOMIC_RELEASE, "agent");
            asm volatile("s_waitcnt vmcnt(0)" ::: "memory");
            const unsigned og = xb_add(&bar[XB_TOP], 1u);
            const unsigned tg = og / nx;
            if (og + 1u == (tg + 1u) * nx) xb_add(&bar[XB_TOPGEN], 1u);
            else XB_SPIN(xb_ld(&bar[XB_TOPGEN]) == tg, bar);
            __builtin_amdgcn_fence(__ATOMIC_ACQUIRE, "agent");
            xb_add(&bar[XB_XGEN(b.x)], 1u);
            asm volatile("s_waitcnt vmcnt(0)" ::: "memory");
        } else {
            XB_SPIN(xb_ld(&bar[XB_XGEN(b.x)]) == gen, bar);
            __builtin_amdgcn_fence(__ATOMIC_ACQUIRE, "agent");
            asm volatile("s_waitcnt vmcnt(0)" ::: "memory");
        }
    }
    __syncthreads();
}
#ifndef N_LAUNCHES
#define N_LAUNCHES 1
#endif
struct Args { const float* in[17]; float* out; unsigned char* ws; int ph_lo, ph_hi; };
struct Frame {
    LAS unsigned char* lds; volatile LAS unsigned* MISC; gu32* ctl;
    int tid, lane, wave, vcu, G;
};
__device__ __forceinline__ float wave_sum(float v) {
#pragma unroll
    for (int o = 1; o < 64; o <<= 1) v += __shfl_xor(v, o);
    return v;
}
__device__ __forceinline__ float wave_max(float v) {
#pragma unroll
    for (int o = 1; o < 64; o <<= 1) v = fmaxf(v, __shfl_xor(v, o));
    return v;
}
__device__ __forceinline__ void p0_transpose_item(const float* W, int K, int N, bf16* WT, LAS float* scr, int item, int lane) {
    const int nblk = N / 32, kb = item / nblk, nb = item % nblk, k0 = 64 * kb, n0 = 32 * nb;
#pragma unroll 8
    for (int i = 0; i < 32; ++i) { const int kk = 2 * i + (lane >> 5); scr[kk * 33 + (lane & 31)] = W[(size_t)(k0 + kk) * N + n0 + (lane & 31)]; }
    LDS_WAIT(); asm volatile("" ::: "memory");
    const int c = lane & 7;
#pragma unroll
    for (int j = 0; j < 4; ++j) { const int n = (lane >> 3) + 8 * j; const LAS float* s = scr + (8 * c) * 33 + n;
        v4u o; o.x = pk2(s[0 * 33], s[1 * 33]); o.y = pk2(s[2 * 33], s[3 * 33]); o.z = pk2(s[4 * 33], s[5 * 33]); o.w = pk2(s[6 * 33], s[7 * 33]);
        *(GAS v4u*)(WT + (size_t)(n0 + n) * K + k0 + 8 * c) = o; }
    LDS_WAIT(); asm volatile("" ::: "memory");
}
__device__ __forceinline__ void p0_wpb_item(const float* wpool, const float* pscale, const float* wop, bf16* WT, int item, int lane) {
    const int nb = item & 15, kb = item >> 4, n = nb * 64 + lane, k0 = kb * 8, g = k0 >> 7, c0 = k0 & 127;
    float acc[8];
#pragma unroll
    for (int i = 0; i < 8; ++i) acc[i] = 0.f;
    const float* wp = wpool + ((size_t)g * 128 + c0) * 128;
    for (int d = 0; d < 128; ++d) {
        const float wo = wop[(size_t)(g * 128 + d) * 1024 + n] * pscale[g * 128 + d];
#pragma unroll
        for (int i = 0; i < 8; ++i) acc[i] += wp[i * 128 + d] * wo;
    }
    v4u o; o.x = pk2(acc[0], acc[1]); o.y = pk2(acc[2], acc[3]); o.z = pk2(acc[4], acc[5]); o.w = pk2(acc[6], acc[7]);
    *(GAS v4u*)(WT + (size_t)n * 512 + k0) = o;
}
__device__ __forceinline__ void p0_prologue(Frame& F, const Args& a) {
    unsigned char* ws = a.ws;
    LAS float* scr = (LAS float*)(F.lds + RING_OFF + F.wave * 16384);
    const int gw = F.vcu * NWAVES + F.wave, NGW = F.G * NWAVES;
    constexpr int I_IN = (D / 64) * (NCOL / 32), I_OA = (WA / 64) * (D / 32), I_OUT = (D / 64) * (D / 32), I_1 = (D / 64) * (FF / 32), I_2 = (FF / 64) * (D / 32), I_PB = 16 * 64;
    constexpr int NITEMS = I_IN + I_OA + I_OUT + I_1 + I_2 + I_PB;
    for (int it = gw; it < NITEMS; it += NGW) {
        int r = it;
        if (r < I_IN) { p0_transpose_item(a.in[1], D, NCOL, (bf16*)(ws + WS_WIN), scr, r, F.lane); continue; } r -= I_IN;
        if (r < I_OA) { p0_transpose_item(a.in[6], WA, D, (bf16*)(ws + WS_WOA), scr, r, F.lane); continue; } r -= I_OA;
        if (r < I_OUT) { p0_transpose_item(a.in[8], D, D, (bf16*)(ws + WS_WOUT), scr, r, F.lane); continue; } r -= I_OUT;
        if (r < I_1) { p0_transpose_item(a.in[11], D, FF, (bf16*)(ws + WS_W1), scr, r, F.lane); continue; } r -= I_1;
        if (r < I_2) { p0_transpose_item(a.in[13], FF, D, (bf16*)(ws + WS_W2), scr, r, F.lane); continue; } r -= I_2;
        p0_wpb_item(a.in[4], a.in[5], a.in[7], (bf16*)(ws + WS_WPB), r, F.lane);
    }
    const GAS f32x4* xs = (const GAS f32x4*)a.in[0]; GAS v4u* xd = (GAS v4u*)(ws + WS_XB);
    for (size_t i = (size_t)gw * 64 + F.lane; i < (size_t)M * D / 8; i += (size_t)NGW * 64) {
        const f32x4 v0 = xs[2 * i], v1 = xs[2 * i + 1];
        v4u o; o.x = pk2(v0.x, v0.y); o.y = pk2(v0.z, v0.w); o.z = pk2(v1.x, v1.y); o.w = pk2(v1.z, v1.w); xd[i] = o;
    }
}
__device__ __forceinline__ void pooled_phase(Frame& F, const bf16* P, bf16* PO) {
    const int gw = F.vcu * NWAVES + F.wave, NGW = F.G * NWAVES;
    const int w = 2 << (F.lane >> 4);
    for (int m = gw; m < M; m += NGW) {
        const int t = m & (SEQ - 1); const int cnt = (t + 1) < w ? (t + 1) : w;
        float s[8], cur[8];
#pragma unroll
        for (int i = 0; i < 8; ++i) s[i] = 0.f;
        const GAS v4u* src = (const GAS v4u*)(P + (size_t)m * 512) + F.lane;
#pragma unroll
        for (int j = 0; j < 16; ++j) {
            if (j < cnt) { const v4u v = src[-(long)j * 64];
                const float e[8] = {bflo(v.x), bfhi(v.x), bflo(v.y), bfhi(v.y), bflo(v.z), bfhi(v.z), bflo(v.w), bfhi(v.w)};
#pragma unroll
                for (int i = 0; i < 8; ++i) { s[i] += e[i]; if (j == 0) cur[i] = e[i]; } }
        }
        const float fc = (float)cnt;
        v4u o; o.x = pk2(s[0] / fc - cur[0], s[1] / fc - cur[1]); o.y = pk2(s[2] / fc - cur[2], s[3] / fc - cur[3]);
        o.z = pk2(s[4] / fc - cur[4], s[5] / fc - cur[5]); o.w = pk2(s[6] / fc - cur[6], s[7] / fc - cur[7]);
        *((GAS v4u*)(PO + (size_t)m * 512) + F.lane) = o;
    }
}
template <int MODE> __device__ __forceinline__ void ln_rows(Frame& F, float* X, const float* gam, const float* bet, bf16* OB, float* stats) {
    const int gw = F.vcu * NWAVES + F.wave, NGW = F.G * NWAVES;
    f32x4 gv[4], bv[4];
#pragma unroll
    for (int j = 0; j < 4; ++j) { gv[j] = ((const GAS f32x4*)gam)[F.lane + 64 * j]; bv[j] = ((const GAS f32x4*)bet)[F.lane + 64 * j]; }
    for (int m = gw; m < M; m += NGW) {
        GAS f32x4* xr = (GAS f32x4*)(X + (size_t)m * D) + F.lane;
        f32x4 v[4]; float s = 0.f;
#pragma unroll
        for (int j = 0; j < 4; ++j) { v[j] = xr[64 * j]; s += (v[j].x + v[j].y) + (v[j].z + v[j].w); }
        const float mean = wave_sum(s) * (1.f / D); float s2 = 0.f;
#pragma unroll
        for (int j = 0; j < 4; ++j) { v[j] = v[j] - mean; s2 += (v[j].x * v[j].x + v[j].y * v[j].y) + (v[j].z * v[j].z + v[j].w * v[j].w); }
        const float rstd = 1.f / sqrtf(wave_sum(s2) * (1.f / D) + LN_EPS);
        if (MODE == 0) {
            GAS unsigned long long* o8 = (GAS unsigned long long*)(OB + (size_t)m * D) + F.lane;
#pragma unroll
            for (int j = 0; j < 4; ++j) { const f32x4 o = v[j] * rstd * gv[j] + bv[j]; o8[64 * j] = (unsigned long long)pk2(o.x, o.y) | ((unsigned long long)pk2(o.z, o.w) << 32); }
            if (F.lane == 0) { stats[2 * (size_t)m] = mean; stats[2 * (size_t)m + 1] = rstd; }
        } else {
#pragma unroll
            for (int j = 0; j < 4; ++j) xr[64 * j] = v[j] * rstd * gv[j] + bv[j];
        }
    }
}
__device__ __forceinline__ int rel_bucket_dev(int n) {
    if (n < 16) return n;
    const int bd[15] = {19, 21, 24, 27, 31, 35, 40, 46, 52, 59, 67, 77, 87, 99, 113};
    int b = 16;
#pragma unroll
    for (int i = 0; i < 15; ++i) b += (n >= bd[i]) ? 1 : 0;
    return b;
}
__device__ __forceinline__ void attn_naive_phase(Frame& F, const bf16* Q, const bf16* K, const bf16* V, const float* ksum, const float* rel_table, bf16* ATT) {
    LAS float* lut = (LAS float*)(F.lds + RING_OFF);
    for (int i = F.tid; i < NH * 128; i += NWAVES * 64) { const int h = i >> 7, n = i & 127; lut[i] = rel_table[rel_bucket_dev(n) * NH + h] * LOG2E; }
    __syncthreads();
    const int gw = F.vcu * NWAVES + F.wave, NGW = F.G * NWAVES, lane = F.lane;
    for (int task = gw; task < M * NH; task += NGW) {
        const int m = task >> 3, h = task & 7, b = m >> 13, t = m & (SEQ - 1), ib = t >> 8;
        float q[64];
        { const GAS v4u* qp = (const GAS v4u*)(Q + (size_t)m * 512 + h * 64);
#pragma unroll
          for (int c = 0; c < 8; ++c) { const v4u v = qp[c]; q[8 * c] = bflo(v.x); q[8 * c + 1] = bfhi(v.x); q[8 * c + 2] = bflo(v.y); q[8 * c + 3] = bfhi(v.y); q[8 * c + 4] = bflo(v.z); q[8 * c + 5] = bfhi(v.z); q[8 * c + 6] = bflo(v.w); q[8 * c + 7] = bfhi(v.w); } }
        float g = -3.0e38f;
        if (lane < ib) { const GAS f32x4* kp = (const GAS f32x4*)(ksum + (size_t)(b * NBLK + lane) * 512 + h * 64); float a = 0.f;
#pragma unroll
            for (int c = 0; c < 16; ++c) { const f32x4 v = kp[c]; a += q[4 * c] * v.x + q[4 * c + 1] * v.y + q[4 * c + 2] * v.z + q[4 * c + 3] * v.w; }
            g = a; }
        int sel[4]; const int nsel = ib < 3 ? ib : 3;
#pragma unroll
        for (int s = 0; s < 3; ++s) {
            float bv = g; int bi = lane;
#pragma unroll
            for (int o = 1; o < 64; o <<= 1) { const float ov = __shfl_xor(bv, o); const int oi = __shfl_xor(bi, o); if (ov > bv || (ov == bv && oi < bi)) { bv = ov; bi = oi; } }
            sel[s] = bi; if (lane == bi) g = -3.0e38f;
        }
        sel[3] = ib;
        float sc[16];
#pragma unroll
        for (int s = 0; s < 4; ++s) {
            const bool valid = (s == 3) || (s < nsel);
            const int jb = (s == 3) ? ib : sel[s];
#pragma unroll
            for (int kk = 0; kk < 4; ++kk) {
                float v = -1.0e30f;
                if (valid) {
                    const int key = jb * BLK + kk * 64 + lane;
                    const GAS v4u* kp = (const GAS v4u*)(K + ((size_t)b * SEQ + key) * 512 + h * 64); float a = 0.f;
#pragma unroll
                    for (int c = 0; c < 8; ++c) { const v4u w = kp[c]; a += q[8 * c] * bflo(w.x) + q[8 * c + 1] * bfhi(w.x) + q[8 * c + 2] * bflo(w.y) + q[8 * c + 3] * bfhi(w.y) + q[8 * c + 4] * bflo(w.z) + q[8 * c + 5] * bfhi(w.z) + q[8 * c + 6] * bflo(w.w) + q[8 * c + 7] * bfhi(w.w); }
                    const int dist = t - key;
                    if (dist >= 0) v = a + lut[h * 128 + (dist < 127 ? dist : 127)];
                }
                sc[s * 4 + kk] = v;
            }
        }
        float mx = sc[0];
#pragma unroll
        for (int i = 1; i < 16; ++i) mx = fmaxf(mx, sc[i]);
        mx = wave_max(mx);
        float l = 0.f;
#pragma unroll
        for (int i = 0; i < 16; ++i) { sc[i] = __builtin_amdgcn_exp2f(sc[i] - mx); l += sc[i]; }
        l = wave_sum(l);
        float o = 0.f;
#pragma unroll
        for (int s = 0; s < 4; ++s) {
            const bool valid = (s == 3) || (s < nsel);
            if (valid) {
                const int jb = (s == 3) ? ib : sel[s];
#pragma unroll
                for (int kk = 0; kk < 4; ++kk) {
                    const bf16* vp = V + ((size_t)b * SEQ + jb * BLK + kk * 64) * 512 + h * 64 + lane;
                    const float pr = sc[s * 4 + kk];
                    for (int l2 = 0; l2 < 64; ++l2) { const float p = __shfl(pr, l2); o += p * __uint_as_float((unsigned)vp[(size_t)l2 * 512] << 16); }
                }
            }
        }
        ATT[(size_t)m * 512 + h * 64 + lane] = (bf16)f2bf(o / l);
    }
    __syncthreads();
}
namespace moba {
typedef short bf16x8 __attribute__((ext_vector_type(8)));
typedef float f32x16 __attribute__((ext_vector_type(16)));
typedef short s16x4 __attribute__((ext_vector_type(4)));
typedef short v4i16_t __attribute__((ext_vector_type(4)));
typedef unsigned u32x4 __attribute__((ext_vector_type(4)));
typedef float f32x2_t __attribute__((ext_vector_type(2))); typedef __bf16 bf16x2_t __attribute__((ext_vector_type(2)));
constexpr int LK = 0, LV = 32768, LSTG = 65536, LSCR = 98304, LLUT = 106496, LPRE = 110592, LCNTL = 114816, LEND = 118912;
constexpr int LIST_PER_BH = 126976;
constexpr int CW_LCNT = 16384;
constexpr size_t OUT_PO = 0, OUT_ML = 96u << 20, OUT_LIST = 104u << 20;
__device__ __forceinline__ int crow(int r, int hi) { return (r & 3) + 8 * (r >> 2) + 4 * hi; }
__device__ __forceinline__ unsigned cvtpk(float lo, float hi) { f32x2_t v = {lo, hi}; bf16x2_t b = __builtin_convertvector(v, bf16x2_t); return __builtin_bit_cast(unsigned, b); }
__device__ __forceinline__ int list_off(int j) { return 256 * (31 * j - (j * (j - 1)) / 2); }
__device__ __forceinline__ s16x4 vtr(const LAS unsigned char* p) { return __builtin_bit_cast(s16x4, __builtin_amdgcn_ds_read_tr16_b64_v4i16((LAS v4i16_t*)p)); }

__device__ __forceinline__ void load_kv_block(const bf16* Kg, const bf16* Vg, LAS unsigned char* lds, int wave, int lane) {
#pragma unroll
    for (int i = 0; i < 4; ++i) {
        const int p = wave * 4 + i;
        { const int c = p & 7, g = p >> 3; const bf16* src = Kg + (size_t)(g * 64 + lane) * 512 + c * 8;
          __builtin_amdgcn_global_load_lds((const unsigned*)src, (LAS unsigned*)(lds + LK + c * 4096 + g * 1024), 16, 0, 0); }
        { const int dh = p >> 4, rg = p & 15; const bf16* src = Vg + (size_t)(rg * 16 + (lane >> 2)) * 512 + dh * 32 + (lane & 3) * 8;
          __builtin_amdgcn_global_load_lds((const unsigned*)src, (LAS unsigned*)(lds + LV + dh * 16384 + rg * 1024), 16, 0, 0); }
    }
}
__device__ __forceinline__ void build_lut(LAS float* lut, const float* rel_table, int tid) {
    for (int i = tid; i < NH * 128; i += NWAVES * 64) { const int h = i >> 7, n = i & 127; lut[i] = rel_table[rel_bucket_dev(n) * NH + h] * LOG2E; }
}
template <bool OWN>
__device__ __forceinline__ void attend(const bf16x8 (&qr)[4], const LAS unsigned char* lds, const LAS float* lut, int dbase, bool use_lut, int ktmax,
                                       int r32, int hi, int lane, f32x16 (&o)[2], float& m_out, float& l_out) {
    f32x16 st[8];
    const LAS unsigned char* kp = lds + LK + hi * 4096 + r32 * 16;
#pragma unroll
    for (int kt = 0; kt < 8; ++kt) {
        if (kt <= ktmax) {
            f32x16 acc;
#pragma unroll
            for (int r = 0; r < 16; ++r) acc[r] = 0.f;
#pragma unroll
            for (int d0 = 0; d0 < 4; ++d0) { const bf16x8 a = *(const LAS bf16x8*)(kp + d0 * 8192 + kt * 512); acc = __builtin_amdgcn_mfma_f32_32x32x16_bf16(a, qr[d0], acc, 0, 0, 0); }
            st[kt] = acc;
        }
    }
    const float c31 = lut[127];
    const int dh = dbase - 4 * hi;
    float mx = -3.0e38f;
#pragma unroll
    for (int kt = 0; kt < 8; ++kt) {
        if (kt <= ktmax) {
            if (use_lut) {
#pragma unroll
                for (int r = 0; r < 16; ++r) { const int dist = dh - (32 * kt + (r & 3) + 8 * (r >> 2)); const int idx = dist < 0 ? 0 : (dist > 127 ? 127 : dist);
                    float s = st[kt][r] + lut[idx]; if (OWN && dist < 0) s = -1.0e30f; st[kt][r] = s; mx = fmaxf(mx, s); }
                asm volatile("" ::: "memory");
            } else {
#pragma unroll
                for (int r = 0; r < 16; ++r) { const float s = st[kt][r] + c31; st[kt][r] = s; mx = fmaxf(mx, s); }
            }
        }
    }
    mx = fmaxf(mx, __shfl_xor(mx, 32));
    float ls = 0.f;
#pragma unroll
    for (int kt = 0; kt < 8; ++kt) {
        if (kt <= ktmax) {
#pragma unroll
            for (int r = 0; r < 16; ++r) { const float p = __builtin_amdgcn_exp2f(st[kt][r] - mx); st[kt][r] = p; ls += p; }
        }
    }
    ls += __shfl_xor(ls, 32);
#pragma unroll
    for (int r = 0; r < 16; ++r) { o[0][r] = 0.f; o[1][r] = 0.f; }
    const LAS unsigned char* vp = lds + LV + ((lane >> 4) & 1) * 32 + (lane & 3) * 8 + (4 * hi + ((lane & 15) >> 2)) * 64;
#pragma unroll
    for (int kt = 0; kt < 8; ++kt) {
        if (kt <= ktmax) {
            u32x4 wa, wb;
            wa.x = cvtpk(st[kt][0], st[kt][1]); wa.y = cvtpk(st[kt][2], st[kt][3]); wa.z = cvtpk(st[kt][4], st[kt][5]); wa.w = cvtpk(st[kt][6], st[kt][7]);
            wb.x = cvtpk(st[kt][8], st[kt][9]); wb.y = cvtpk(st[kt][10], st[kt][11]); wb.z = cvtpk(st[kt][12], st[kt][13]); wb.w = cvtpk(st[kt][14], st[kt][15]);
            const bf16x8 pa = __builtin_bit_cast(bf16x8, wa), pb = __builtin_bit_cast(bf16x8, wb);
#pragma unroll
            for (int d0 = 0; d0 < 2; ++d0) {
                const LAS unsigned char* v0 = vp + d0 * 16384 + kt * 2048;
                const s16x4 l0 = vtr(v0), h0 = vtr(v0 + 512), l1 = vtr(v0 + 1024), h1 = vtr(v0 + 1536);
                const bf16x8 va = (bf16x8){l0[0], l0[1], l0[2], l0[3], h0[0], h0[1], h0[2], h0[3]}, vb = (bf16x8){l1[0], l1[1], l1[2], l1[3], h1[0], h1[1], h1[2], h1[3]};
                o[d0] = __builtin_amdgcn_mfma_f32_32x32x16_bf16(pa, va, o[d0], 0, 0, 0);
                o[d0] = __builtin_amdgcn_mfma_f32_32x32x16_bf16(pb, vb, o[d0], 0, 0, 0);
            }
        }
    }
    m_out = mx; l_out = ls;
}
__device__ __forceinline__ void attend_own(const bf16x8 (&qr)[4], const LAS unsigned char* lds, const LAS float* lut, int dbase, int ktmax,
                                           int r32, int hi, int lane, f32x16 (&o)[2], float& m_out, float& l_out) {
    const LAS unsigned char* kp = lds + LK + hi * 4096 + r32 * 16;
    const int dh = dbase - 4 * hi;
    float mx = -3.0e38f;
    for (int kt = 0; kt <= ktmax; ++kt) {
        f32x16 acc;
#pragma unroll
        for (int r = 0; r < 16; ++r) acc[r] = 0.f;
#pragma unroll
        for (int d0 = 0; d0 < 4; ++d0) { const bf16x8 a = *(const LAS bf16x8*)(kp + d0 * 8192 + kt * 512); acc = __builtin_amdgcn_mfma_f32_32x32x16_bf16(a, qr[d0], acc, 0, 0, 0); }
#pragma unroll
        for (int r = 0; r < 16; ++r) { const int dist = dh - (32 * kt + (r & 3) + 8 * (r >> 2)); const int idx = dist < 0 ? 0 : (dist > 127 ? 127 : dist);
            const float s = (dist < 0) ? -1.0e30f : acc[r] + lut[idx]; mx = fmaxf(mx, s); }
    }
    mx = fmaxf(mx, __shfl_xor(mx, 32));
    float ls = 0.f;
#pragma unroll
    for (int r = 0; r < 16; ++r) { o[0][r] = 0.f; o[1][r] = 0.f; }
    const LAS unsigned char* vp = lds + LV + ((lane >> 4) & 1) * 32 + (lane & 3) * 8 + (4 * hi + ((lane & 15) >> 2)) * 64;
    for (int kt = 0; kt <= ktmax; ++kt) {
        f32x16 acc;
#pragma unroll
        for (int r = 0; r < 16; ++r) acc[r] = 0.f;
#pragma unroll
        for (int d0 = 0; d0 < 4; ++d0) { const bf16x8 a = *(const LAS bf16x8*)(kp + d0 * 8192 + kt * 512); acc = __builtin_amdgcn_mfma_f32_32x32x16_bf16(a, qr[d0], acc, 0, 0, 0); }
#pragma unroll
        for (int r = 0; r < 16; ++r) { const int dist = dh - (32 * kt + (r & 3) + 8 * (r >> 2)); const int idx = dist < 0 ? 0 : (dist > 127 ? 127 : dist);
            const float s = (dist < 0) ? -1.0e30f : acc[r] + lut[idx]; const float p = __builtin_amdgcn_exp2f(s - mx); acc[r] = p; ls += p; }
        u32x4 wa, wb;
        wa.x = cvtpk(acc[0], acc[1]); wa.y = cvtpk(acc[2], acc[3]); wa.z = cvtpk(acc[4], acc[5]); wa.w = cvtpk(acc[6], acc[7]);
        wb.x = cvtpk(acc[8], acc[9]); wb.y = cvtpk(acc[10], acc[11]); wb.z = cvtpk(acc[12], acc[13]); wb.w = cvtpk(acc[14], acc[15]);
        const bf16x8 pa = __builtin_bit_cast(bf16x8, wa), pb = __builtin_bit_cast(bf16x8, wb);
#pragma unroll
        for (int d0 = 0; d0 < 2; ++d0) {
            const LAS unsigned char* v0 = vp + d0 * 16384 + kt * 2048;
            const s16x4 l0 = vtr(v0), h0 = vtr(v0 + 512), l1 = vtr(v0 + 1024), h1 = vtr(v0 + 1536);
            const bf16x8 va = (bf16x8){l0[0], l0[1], l0[2], l0[3], h0[0], h0[1], h0[2], h0[3]}, vb = (bf16x8){l1[0], l1[1], l1[2], l1[3], h1[0], h1[1], h1[2], h1[3]};
            o[d0] = __builtin_amdgcn_mfma_f32_32x32x16_bf16(pa, va, o[d0], 0, 0, 0);
            o[d0] = __builtin_amdgcn_mfma_f32_32x32x16_bf16(pb, vb, o[d0], 0, 0, 0);
        }
    }
    ls += __shfl_xor(ls, 32);
    m_out = mx; l_out = ls;
}
__device__ __forceinline__ void stage_o(const f32x16 (&o)[2], LAS unsigned short* stg, const LAS float* rowf, int r32, int hi) {
#pragma unroll
    for (int r = 0; r < 16; ++r) { const int row = crow(r, hi); const float f = rowf[row];
#pragma unroll
        for (int d0 = 0; d0 < 2; ++d0) stg[row * 64 + d0 * 32 + r32] = (unsigned short)(cvtpk(o[d0][r] * f, 0.f) & 0xffffu); }
}

__device__ __forceinline__ void gate_phase(Frame& F, const bf16* Q, const float* ksum, unsigned* lcnt, unsigned* lists) {
    LAS unsigned* cnt = (LAS unsigned*)(F.lds + RING_OFF + LSCR);
    const int lane = F.lane, r32 = lane & 31, hi = lane >> 5, w = F.wave;
    for (int k = 0; k < 4; ++k) {
        const int u = F.vcu * 4 + k, bh = u >> 5, ib = u & 31, b = bh >> 3, h = bh & 7;
        if (F.tid < 64) cnt[F.tid] = 0u;
        __syncthreads();
        const int t = ib * 256 + 32 * w + r32; const size_t m = (size_t)b * SEQ + t;
        bf16x8 qr[4];
#pragma unroll
        for (int d0 = 0; d0 < 4; ++d0) qr[d0] = *(const bf16x8*)(Q + m * 512 + h * 64 + 16 * d0 + 8 * hi);
        f32x16 g;
#pragma unroll
        for (int r = 0; r < 16; ++r) g[r] = 0.f;
        const float* kr = ksum + (size_t)(b * NBLK + r32) * 512 + h * 64 + 8 * hi;
#pragma unroll
        for (int d0 = 0; d0 < 4; ++d0) {
            const f32x4 a0 = *(const f32x4*)(kr + 16 * d0), a1 = *(const f32x4*)(kr + 16 * d0 + 4);
            const float e[8] = {a0.x, a0.y, a0.z, a0.w, a1.x, a1.y, a1.z, a1.w};
            u32x4 wh, wl;
            unsigned hh[8], ll[8];
#pragma unroll
            for (int i = 0; i < 8; ++i) { hh[i] = f2bf(e[i]); ll[i] = f2bf(e[i] - __uint_as_float(hh[i] << 16)); }
            wh.x = hh[0] | (hh[1] << 16); wh.y = hh[2] | (hh[3] << 16); wh.z = hh[4] | (hh[5] << 16); wh.w = hh[6] | (hh[7] << 16);
            wl.x = ll[0] | (ll[1] << 16); wl.y = ll[2] | (ll[3] << 16); wl.z = ll[4] | (ll[5] << 16); wl.w = ll[6] | (ll[7] << 16);
            g = __builtin_amdgcn_mfma_f32_32x32x16_bf16(__builtin_bit_cast(bf16x8, wh), qr[d0], g, 0, 0, 0);
            g = __builtin_amdgcn_mfma_f32_32x32x16_bf16(__builtin_bit_cast(bf16x8, wl), qr[d0], g, 0, 0, 0);
        }
        float v[16];
#pragma unroll
        for (int r = 0; r < 16; ++r) v[r] = (crow(r, hi) < ib) ? g[r] : -3.0e38f;
        float tv[3]; int ti[3];
#pragma unroll
        for (int s = 0; s < 3; ++s) {
            float bv = v[0]; int br = 0;
#pragma unroll
            for (int r = 1; r < 16; ++r) if (v[r] > bv) { bv = v[r]; br = r; }
            tv[s] = bv; ti[s] = crow(br, hi);
#pragma unroll
            for (int r = 0; r < 16; ++r) if (r == br) v[r] = -3.4e38f;
        }
        float cv[6]; int ci[6];
#pragma unroll
        for (int s = 0; s < 3; ++s) { cv[s] = tv[s]; ci[s] = ti[s]; cv[3 + s] = __shfl_xor(tv[s], 32); ci[3 + s] = __shfl_xor(ti[s], 32); }
        int sel[3];
#pragma unroll
        for (int s = 0; s < 3; ++s) {
            float bv = cv[0]; int bi = ci[0];
#pragma unroll
            for (int c = 1; c < 6; ++c) if (cv[c] > bv || (cv[c] == bv && ci[c] < bi)) { bv = cv[c]; bi = ci[c]; }
            sel[s] = bi;
#pragma unroll
            for (int c = 0; c < 6; ++c) if (ci[c] == bi) cv[c] = -3.4e38f;
        }
        const int nsel = ib < 3 ? ib : 3;
        unsigned pos[3];
#pragma unroll
        for (int s = 0; s < 3; ++s) { pos[s] = 0u; if (hi == 0 && s < nsel) pos[s] = __hip_atomic_fetch_add(cnt + sel[s], 1u, __ATOMIC_RELAXED, __HIP_MEMORY_SCOPE_WORKGROUP); }
        __syncthreads();
        if (F.tid < 32) { const unsigned c = cnt[F.tid]; cnt[32 + F.tid] = c ? __hip_atomic_fetch_add(lcnt + bh * 32 + F.tid, c, __ATOMIC_RELAXED, __HIP_MEMORY_SCOPE_AGENT) : 0u; }
        __syncthreads();
#pragma unroll
        for (int s = 0; s < 3; ++s) if (hi == 0 && s < nsel) { const int j = sel[s]; lists[(size_t)bh * LIST_PER_BH + list_off(j) + cnt[32 + j] + pos[s]] = (unsigned)t | ((unsigned)s << 13); }
        __syncthreads();
    }
}
__device__ __forceinline__ void sel_phase(Frame& F, const bf16* Q, const bf16* K, const bf16* V, const float* rel_table, const unsigned* lcnt, const unsigned* lists, bf16* PO, float* ML) {
    LAS unsigned char* lds = F.lds + RING_OFF;
    LAS float* lut = (LAS float*)(lds + LLUT); LAS int* pre = (LAS int*)(lds + LPRE); LAS int* cntl = (LAS int*)(lds + LCNTL);
    const int lane = F.lane, r32 = lane & 31, hi = lane >> 5, w = F.wave, tid = F.tid;
    LAS float* scr = (LAS float*)(lds + LSCR) + w * 256; LAS unsigned short* stg = (LAS unsigned short*)(lds + LSTG + w * 4096);
    build_lut(lut, rel_table, tid);
    {
        const int n0 = (int)lcnt[2 * tid], n1 = (int)lcnt[2 * tid + 1]; const int c0 = (n0 + 255) >> 8, c1 = (n1 + 255) >> 8;
        cntl[2 * tid] = n0; cntl[2 * tid + 1] = n1;
        int s = c0 + c1;
#pragma unroll
        for (int o = 1; o < 64; o <<= 1) { const int y = __shfl_up(s, o); if (lane >= o) s += y; }
        LAS int* wsum = (LAS int*)(lds + LSCR);
        if (lane == 63) wsum[w] = s;
        __syncthreads();
        int base = 0;
#pragma unroll
        for (int i = 0; i < 8; ++i) if (i < w) base += wsum[i];
        const int excl = base + s - (c0 + c1);
        pre[2 * tid] = excl; pre[2 * tid + 1] = excl + c0;
        if (tid == 511) pre[1024] = excl + c0 + c1;
        __syncthreads();
    }
    const int T = pre[1024];
    const int x0 = (int)(((long)F.vcu * T) / F.G), x1 = (int)(((long)(F.vcu + 1) * T) / F.G);
    int curL = -1;
    for (int x = x0; x < x1; ++x) {
        int lo = 0, hi_ = 1024;
        while (hi_ - lo > 1) { const int mid = (lo + hi_) >> 1; if (pre[mid] <= x) lo = mid; else hi_ = mid; }
        const int L = lo, ci = x - pre[L], n = cntl[L], b = L >> 8, h = (L >> 5) & 7, j = L & 31;
        if (L != curL) {
            __syncthreads();
            load_kv_block(K + ((size_t)b * SEQ + j * BLK) * 512 + h * 64, V + ((size_t)b * SEQ + j * BLK) * 512 + h * 64, lds, w, lane);
            asm volatile("s_waitcnt vmcnt(0)" ::: "memory");
            __syncthreads();
            curL = L;
        }
        const int first = ci * 256 + w * 32;
        if (first < n) {
            const int idx = first + r32; const bool valid = idx < n;
            const unsigned e = lists[(size_t)(L >> 5) * LIST_PER_BH + list_off(j) + (valid ? idx : first)];
            const int t = (int)(e & 8191u), slot = (int)(e >> 13); const size_t m = (size_t)b * SEQ + t;
            bf16x8 qr[4];
#pragma unroll
            for (int d0 = 0; d0 < 4; ++d0) qr[d0] = *(const bf16x8*)(Q + m * 512 + h * 64 + 16 * d0 + 8 * hi);
            const int dbase = t - j * BLK;
            const bool use_lut = __any((dbase - 255) < 113);
            f32x16 o[2]; float mx, ls;
            attend<false>(qr, lds, lut + h * 128, dbase, use_lut, 7, r32, hi, lane, o, mx, ls);
            const int dst = valid ? (int)((size_t)slot * ((size_t)M * NH) + m * NH + h) : -1;
            if (hi == 0) { scr[r32] = 1.0f / ls; ((LAS int*)scr)[32 + r32] = dst; if (valid) { ML[2 * (size_t)dst] = mx; ML[2 * (size_t)dst + 1] = ls; } }
            stage_o(o, stg, scr, r32, hi);
#pragma unroll
            for (int i = 0; i < 4; ++i) { const int row = i * 8 + (lane >> 3), ch = lane & 7; const u32x4 vv = *(const LAS u32x4*)(stg + row * 64 + ch * 8); const int d = ((LAS int*)scr)[32 + row];
                if (d >= 0) *(u32x4*)(PO + (size_t)d * 64 + ch * 8) = vv; }
        }
    }
    __syncthreads();
}
__device__ __forceinline__ void own_phase(Frame& F, const bf16* Q, const bf16* K, const bf16* V, const float* rel_table, const bf16* PO, const float* ML, bf16* ATT) {
    LAS unsigned char* lds = F.lds + RING_OFF;
    LAS float* lut = (LAS float*)(lds + LLUT);
    const int lane = F.lane, r32 = lane & 31, hi = lane >> 5, w = F.wave, tid = F.tid;
    LAS float* scr = (LAS float*)(lds + LSCR) + w * 256; LAS unsigned short* stg = (LAS unsigned short*)(lds + LSTG + w * 4096);
    build_lut(lut, rel_table, tid);
    for (int k = 0; k < 4; ++k) {
        const int u = F.vcu * 4 + k, bh = u >> 5, ib = u & 31, b = bh >> 3, h = bh & 7;
        __syncthreads();
        load_kv_block(K + ((size_t)b * SEQ + ib * BLK) * 512 + h * 64, V + ((size_t)b * SEQ + ib * BLK) * 512 + h * 64, lds, w, lane);
        asm volatile("s_waitcnt vmcnt(0)" ::: "memory");
        __syncthreads();
        const int tl = 32 * w + r32; const size_t m = (size_t)b * SEQ + ib * BLK + tl;
        bf16x8 qr[4];
#pragma unroll
        for (int d0 = 0; d0 < 4; ++d0) qr[d0] = *(const bf16x8*)(Q + m * 512 + h * 64 + 16 * d0 + 8 * hi);
        f32x16 o[2]; float mx, ls;
        attend_own(qr, lds, lut + h * 128, tl, w, r32, hi, lane, o, mx, ls);
        const int nsel = ib < 3 ? ib : 3;
        if (hi == 0) {
            float ms[3], lsv[3]; float Mx = mx;
#pragma unroll
            for (int s = 0; s < 3; ++s) { ms[s] = -3.0e38f; lsv[s] = 0.f; if (s < nsel) { const size_t d = (size_t)s * ((size_t)M * NH) + m * NH + h; ms[s] = ML[2 * d]; lsv[s] = ML[2 * d + 1]; Mx = fmaxf(Mx, ms[s]); } }
            const float wo = ls * __builtin_amdgcn_exp2f(mx - Mx); float tot = wo; float wsel[3];
#pragma unroll
            for (int s = 0; s < 3; ++s) { wsel[s] = (s < nsel) ? lsv[s] * __builtin_amdgcn_exp2f(ms[s] - Mx) : 0.f; tot += wsel[s]; }
            const float inv = 1.0f / tot;
            scr[r32] = (wo * inv) / ls;
#pragma unroll
            for (int s = 0; s < 3; ++s) scr[64 + r32 * 4 + s] = wsel[s] * inv;
        }
        stage_o(o, stg, scr, r32, hi);
#pragma unroll
        for (int i = 0; i < 4; ++i) {
            const int row = i * 8 + (lane >> 3), ch = lane & 7; const size_t mr = (size_t)b * SEQ + ib * BLK + 32 * w + row;
            const u32x4 own = *(const LAS u32x4*)(stg + row * 64 + ch * 8);
            float a[8] = {bflo(own.x), bfhi(own.x), bflo(own.y), bfhi(own.y), bflo(own.z), bfhi(own.z), bflo(own.w), bfhi(own.w)};
#pragma unroll
            for (int s = 0; s < 3; ++s) if (s < nsel) { const float ws = scr[64 + row * 4 + s]; const u32x4 p = *(const u32x4*)(PO + ((size_t)s * ((size_t)M * NH) + mr * NH + h) * 64 + ch * 8);
                a[0] += ws * bflo(p.x); a[1] += ws * bfhi(p.x); a[2] += ws * bflo(p.y); a[3] += ws * bfhi(p.y); a[4] += ws * bflo(p.z); a[5] += ws * bfhi(p.z); a[6] += ws * bflo(p.w); a[7] += ws * bfhi(p.w); }
            u32x4 ov; ov.x = cvtpk(a[0], a[1]); ov.y = cvtpk(a[2], a[3]); ov.z = cvtpk(a[4], a[5]); ov.w = cvtpk(a[6], a[7]);
            *(u32x4*)(ATT + mr * 512 + h * 64 + ch * 8) = ov;
        }
    }
    __syncthreads();
}
}
constexpr int N_PHASES = 11;
__global__ void __launch_bounds__(NWAVES * 64, 2) moba_fwd(Args args) {
    extern __shared__ __attribute__((aligned(16))) unsigned char lds[];
    const int ph_lo = args.ph_lo, ph_hi = args.ph_hi;
#define IN(k) (ph_lo <= (k) && (k) < ph_hi)
#define BOTH(k) (IN(k) && IN((k) + 1))
    Frame F;
    F.lds = (LAS unsigned char*)lds;
    F.MISC = (volatile LAS unsigned*)(F.lds + MISC_OFF);
    F.tid = threadIdx.x; F.lane = F.tid & 63; F.wave = __builtin_amdgcn_readfirstlane(F.tid >> 6);
    F.G = gridDim.x; { const int bx = blockIdx.x; F.vcu = (F.G % 8 == 0) ? (bx % 8) * (F.G / 8) + bx / 8 : bx; }
    unsigned char* ws = args.ws;
    F.ctl = (gu32*)(ws + WS_CTL);
    for (int u = F.tid; u < (LDS_BYTES - LDSCTL_OFF) / 4; u += NWAVES * 64) ((LAS unsigned*)(F.lds + LDSCTL_OFF))[u] = 0u;
    __syncthreads();
    XcdBarrier bar; bar.bar = (unsigned*)(F.ctl + CW_BAR); bar.x = 0; bar.st = nullptr;
    if (ph_hi - ph_lo > 1) bar = xcd_barrier_post((unsigned*)(F.ctl + CW_BAR), F.MISC + 8);
#define GRID_BAR(k) do { if (BOTH(k)) xcd_barrier(bar); } while (0)
    bf16* const Win_t = (bf16*)(ws + WS_WIN); bf16* const Woa_t = (bf16*)(ws + WS_WOA); bf16* const Wpb_t = (bf16*)(ws + WS_WPB);
    bf16* const Wout_t = (bf16*)(ws + WS_WOUT); bf16* const W1_t = (bf16*)(ws + WS_W1); bf16* const W2_t = (bf16*)(ws + WS_W2);
    bf16* const XB = (bf16*)(ws + WS_XB); bf16* const QKVP = (bf16*)(ws + WS_QKVP); bf16* const GT = (bf16*)(ws + WS_G);
    bf16* const POOLED = (bf16*)(ws + WS_POOLED); bf16* const ATT = (bf16*)(ws + WS_ATT); bf16* const U = (bf16*)(ws + WS_U);
    float* const HPRE = (float*)(ws + WS_HPRE); bf16* const HB = (bf16*)(ws + WS_HB); bf16* const FB = (bf16*)(ws + WS_F);
    float* const KSUM = (float*)(ws + WS_KSUM); float* const STATS = (float*)(ws + WS_STATS);
    const bf16* Qb = QKVP; const bf16* Kb = QKVP + (size_t)M * 512; const bf16* Vb = QKVP + (size_t)2 * M * 512; const bf16* Pb = QKVP + (size_t)3 * M * 512;
    unsigned* const LCNT = (unsigned*)(F.ctl + moba::CW_LCNT);
    unsigned char* const ob = (unsigned char*)args.out;
    bf16* const PO = (bf16*)(ob + moba::OUT_PO); float* const ML = (float*)(ob + moba::OUT_ML); unsigned* const LISTS = (unsigned*)(ob + moba::OUT_LIST);

    if (IN(0)) { p0_prologue(F, args); GRID_BAR(0); }
    if (IN(1)) { pg8::Gemm g{XB, Win_t, M, NCOL, D}; pg8::StaticOrder S; S.init(M, NCOL, F.G, (int)blockIdx.x);
      pg8::EpiProj E{QKVP, GT, args.in[2], KSUM, QSCALE};
      pg8::gemm_phase<pg8::EpiProj, pg8::StaticOrder, true, true>(F.lds + RING_OFF, g, S, E); GRID_BAR(1); }
    if (IN(2)) { pooled_phase(F, Pb, POOLED);
#if !defined(ATTN_NAIVE)
      moba::gate_phase(F, Qb, KSUM, LCNT, LISTS);
#endif
      GRID_BAR(2); }
    if (IN(3)) { { pg8::Gemm g{POOLED, Wpb_t, M, D, WA}; pg8::StaticOrder S; S.init(M, D, F.G, (int)blockIdx.x);
      pg8::EpiBranch<false> E{U, GT};
      pg8::gemm_phase<pg8::EpiBranch<false>, pg8::StaticOrder, true, true>(F.lds + RING_OFF, g, S, E); }
#if defined(ATTN_NAIVE)
      attn_naive_phase(F, Qb, Kb, Vb, KSUM, args.in[3], ATT);
#else
      moba::sel_phase(F, Qb, Kb, Vb, args.in[3], LCNT, LISTS, PO, ML);
#endif
      GRID_BAR(3); }
    if (IN(4)) {
#if !defined(ATTN_NAIVE)
      moba::own_phase(F, Qb, Kb, Vb, args.in[3], PO, ML, ATT);
#endif
      GRID_BAR(4); }
    if (IN(5)) { pg8::Gemm g{ATT, Woa_t, M, D, WA}; pg8::StaticOrder S; S.init(M, D, F.G, (int)blockIdx.x);
      pg8::EpiBranch<true> E{U, GT};
      pg8::gemm_phase<pg8::EpiBranch<true>, pg8::StaticOrder, true, true>(F.lds + RING_OFF, g, S, E); GRID_BAR(5); }
    if (IN(6)) { pg8::Gemm g{U, Wout_t, M, D, D}; pg8::StaticOrder S; S.init(M, D, F.G, (int)blockIdx.x);
      pg8::EpiMix E{args.in[0], HPRE, ALPHA};
      pg8::gemm_phase<pg8::EpiMix, pg8::StaticOrder, true, true>(F.lds + RING_OFF, g, S, E); GRID_BAR(6); }
    if (IN(7)) { ln_rows<0>(F, HPRE, args.in[9], args.in[10], HB, STATS); GRID_BAR(7); }
    if (IN(8)) { pg8::Gemm g{HB, W1_t, M, FF, D}; pg8::StaticOrder S; S.init(M, FF, F.G, (int)blockIdx.x);
      pg8::EpiFF1 E{FB, args.in[12]};
      pg8::gemm_phase<pg8::EpiFF1, pg8::StaticOrder, true, true>(F.lds + RING_OFF, g, S, E); GRID_BAR(8); }
    if (IN(9)) { pg8::Gemm g{FB, W2_t, M, D, FF}; pg8::StaticOrder S; S.init(M, D, F.G, (int)blockIdx.x);
      pg8::EpiFF2 E{HPRE, STATS, args.in[9], args.in[10], args.in[14], args.out, ALPHA};
      pg8::gemm_phase<pg8::EpiFF2, pg8::StaticOrder, true, true>(F.lds + RING_OFF, g, S, E); GRID_BAR(9); }
    if (IN(10)) ln_rows<1>(F, args.out, args.in[15], args.in[16], nullptr, nullptr);
#undef IN
#undef BOTH
}

extern "C" void kernel_launch(void* const* d_in, const int* in_sizes, int n_in, void* d_out, int out_size, void* d_ws, size_t ws_size, hipStream_t stream) {
    static int grid = 0;
    if (grid == 0) {
        if (n_in != 17 || in_sizes[0] != M * D || out_size != M * D || ws_size < WS_END) { fprintf(stderr, "kernel_launch: unexpected shapes (n_in %d, in0 %d, out %d, ws %zu); nothing launched\n", n_in, n_in > 0 ? in_sizes[0] : -1, out_size, ws_size); grid = -1; return; }
        int dev = 0, cus = 0, per_cu = 0;
        if (hipGetDevice(&dev) != hipSuccess || hipDeviceGetAttribute(&cus, hipDeviceAttributeMultiprocessorCount, dev) != hipSuccess) { grid = -1; return; }
        if (hipFuncSetAttribute((const void*)moba_fwd, hipFuncAttributeMaxDynamicSharedMemorySize, LDS_BYTES) != hipSuccess) { fprintf(stderr, "kernel_launch: hipFuncSetAttribute failed\n"); grid = -1; return; }
        if (hipOccupancyMaxActiveBlocksPerMultiprocessor(&per_cu, (const void*)moba_fwd, NWAVES * 64, LDS_BYTES) != hipSuccess || per_cu < 1) { fprintf(stderr, "kernel_launch: occupancy query says %d blocks per CU\n", per_cu); }
        (void)hipGetLastError();
        grid = cus;
    }
    if (grid < 0) return;
    (void)hipMemsetAsync((char*)d_ws + WS_CTL, 0, CTL_ZERO_BYTES, stream);
    Args a{};
    for (int i = 0; i < 17; ++i) a.in[i] = (const float*)d_in[i];
    a.out = (float*)d_out; a.ws = (unsigned char*)d_ws;
#if N_LAUNCHES == 1
    a.ph_lo = 0; a.ph_hi = N_PHASES;
    hipLaunchKernelGGL(moba_fwd, dim3(grid), dim3(NWAVES * 64), LDS_BYTES, stream, a);
#else
    for (int p = 0; p < N_PHASES; ++p) { a.ph_lo = p; a.ph_hi = p + 1; hipLaunchKernelGGL(moba_fwd, dim3(grid), dim3(NWAVES * 64), LDS_BYTES, stream, a); }
#endif
}
```

```cpp
#include <hip/hip_runtime.h>
#include <cstdio>
#include <cstdint>
constexpr int MROWS = 32768;
namespace pg8 {
#define PG8_LAS __attribute__((address_space(3)))
typedef unsigned short bf16_t;
typedef short bf16x8 __attribute__((ext_vector_type(8)));
typedef float f32x4 __attribute__((ext_vector_type(4)));
typedef unsigned u32x4 __attribute__((ext_vector_type(4)));
constexpr int BM = 256, BK = 64, HALF = 128, HTB = HALF * BK * 2  , STAGE_BYTES = 8 * HTB, NXCD = 8, WGM = 8;

__host__ __device__ __forceinline__ int lds_byte(int r, int c) { const int st = (r >> 4) * 2 + (c >> 5), rr = r & 15, cc = c & 31, ob = rr * 64 + cc * 2; return st * 1024 + (ob ^ (((ob >> 9) & 1) << 5)); }
__host__ __device__ __forceinline__ void stage_rc(int b, int& R, int& C) { const int st = b / 1024, sb = b % 1024, swz = sb ^ (((sb >> 9) & 1) << 5); R = (st >> 1) * 16 + swz / 64; C = (st & 1) * 32 + (swz % 64) / 2; }
__host__ __device__ __forceinline__ int perm32(int rho) { const int n = rho >> 4, i = rho & 15; return 8 * (i >> 2) + 4 * n + (i & 3); }

struct Unit { int pm, pn; };
struct Gemm { const bf16_t* A; const bf16_t* Bt; int M, N, K; };

struct StaticOrder {
    int nM, nN, nwg, G, c;
    __host__ __device__ void init(int M, int N, int G_, int c_) { nM = M / BM; nN = N / BM; nwg = nM * nN; G = G_; c = c_; }
    __host__ __device__ bool next(int i, Unit& u) const {
        const long L = (long)i * G + c; if (L >= nwg) return false;
        int wgid = (int)L; { const int q = nwg / NXCD, r = nwg % NXCD, xcd = wgid % NXCD, off = wgid / NXCD; wgid = (xcd < r ? xcd * (q + 1) : r * (q + 1) + (xcd - r) * q) + off; }
        const int nig = WGM * nN, gid = wgid / nig, fm = gid * WGM, gsz = (nM - fm) < WGM ? (nM - fm) : WGM;
        u.pm = fm + ((wgid % nig) % gsz); u.pn = (wgid % nig) / gsz; return true;
    }
    __device__ __forceinline__ void a_ready(const Unit&) const {}
    __device__ __forceinline__ void done(const Unit&) const {}
};

typedef float f32x2_t __attribute__((ext_vector_type(2))); typedef __bf16 bf16x2_t __attribute__((ext_vector_type(2)));
__device__ __forceinline__ unsigned cvt_pk_bf16(float lo, float hi) { f32x2_t v = {lo, hi}; bf16x2_t b = __builtin_convertvector(v, bf16x2_t); return __builtin_bit_cast(unsigned, b); }
__device__ __forceinline__ float bf_lo(unsigned w) { return __uint_as_float(w << 16); }
__device__ __forceinline__ float bf_hi(unsigned w) { return __uint_as_float(w & 0xffff0000u); }
__device__ __forceinline__ float sigmoidf_fast(float x) { return __builtin_amdgcn_rcpf(1.0f + __builtin_amdgcn_exp2f(-1.4426950408889634f * x)); }
__device__ __forceinline__ u32x4 pack8(const f32x4 v0, const f32x4 v1) { u32x4 w; w.x = cvt_pk_bf16(v0[0], v0[1]); w.y = cvt_pk_bf16(v0[2], v0[3]); w.z = cvt_pk_bf16(v1[0], v1[1]); w.w = cvt_pk_bf16(v1[2], v1[3]); return w; }

struct EpiProj {
    static constexpr bool PERM = true, AFTER_DRAIN = false;
    bf16_t* QKVP; bf16_t* G; const float* bgate; float* ksum; float qscale;
    __device__ __forceinline__ void operator()(const f32x4 (&acc)[2][2][4][2], const Unit& u, int wr, int wc, int fr, int fq) const {
        const int row0 = u.pm * BM + wr * 64 + fr;
        if (u.pn < 8) {
            const int t = u.pn >> 1;
            bf16_t* base = QKVP + (size_t)t * ((size_t)MROWS * 512);
            const int col0 = (u.pn & 1) * 256 + wc * 32 + 8 * fq;
            const float sc = (t == 0) ? qscale : 1.f;
#pragma unroll
            for (int ai = 0; ai < 2; ++ai)
#pragma unroll
                for (int m = 0; m < 4; ++m) { bf16_t* rowp = base + (size_t)(row0 + ai * HALF + m * 16) * 512 + col0;
#pragma unroll
                    for (int bj = 0; bj < 2; ++bj) *(u32x4*)(rowp + bj * HALF) = pack8(acc[ai][bj][m][0] * sc, acc[ai][bj][m][1] * sc); }
            if (t == 1) {
#pragma unroll
                for (int bj = 0; bj < 2; ++bj)
#pragma unroll
                    for (int n = 0; n < 2; ++n) { f32x4 s = (f32x4){0.f, 0.f, 0.f, 0.f};
#pragma unroll
                        for (int ai = 0; ai < 2; ++ai)
#pragma unroll
                            for (int m = 0; m < 4; ++m) s += acc[ai][bj][m][n];
#pragma unroll
                        for (int e = 0; e < 4; ++e) { float v = s[e]; v += __shfl_xor(v, 1); v += __shfl_xor(v, 2); v += __shfl_xor(v, 4); v += __shfl_xor(v, 8);
                            if (fr == 0) unsafeAtomicAdd(ksum + (size_t)u.pm * 512 + col0 + bj * HALF + 4 * n + e, v); } }
            }
        } else {
            const int gcol0 = (u.pn - 8) * 256 + wc * 32 + 8 * fq;
            f32x4 bv[2][2];
#pragma unroll
            for (int bj = 0; bj < 2; ++bj)
#pragma unroll
                for (int n = 0; n < 2; ++n) bv[bj][n] = *(const f32x4*)(bgate + gcol0 + bj * HALF + 4 * n);
#pragma unroll
            for (int ai = 0; ai < 2; ++ai)
#pragma unroll
                for (int m = 0; m < 4; ++m) { bf16_t* rowp = G + (size_t)(row0 + ai * HALF + m * 16) * 2048 + gcol0;
#pragma unroll
                    for (int bj = 0; bj < 2; ++bj) { f32x4 v0 = acc[ai][bj][m][0] + bv[bj][0], v1 = acc[ai][bj][m][1] + bv[bj][1];
#pragma unroll
                        for (int e = 0; e < 4; ++e) { v0[e] = sigmoidf_fast(v0[e]); v1[e] = sigmoidf_fast(v1[e]); }
                        *(u32x4*)(rowp + bj * HALF) = pack8(v0, v1); } }
        }
    }
};
template <bool ADD> struct EpiBranch {
    static constexpr bool PERM = true, AFTER_DRAIN = false;
    bf16_t* U; const bf16_t* G;
    __device__ __forceinline__ void operator()(const f32x4 (&acc)[2][2][4][2], const Unit& u, int wr, int wc, int fr, int fq) const {
        const int row0 = u.pm * BM + wr * 64 + fr, col0 = u.pn * BM + wc * 32 + 8 * fq;
#pragma unroll
        for (int ai = 0; ai < 2; ++ai)
#pragma unroll
            for (int m = 0; m < 4; ++m) { const size_t r = (size_t)(row0 + ai * HALF + m * 16);
#pragma unroll
                for (int bj = 0; bj < 2; ++bj) { const int c = col0 + bj * HALF;
                    const u32x4 g = *(const u32x4*)(G + r * 2048 + (ADD ? 0 : 1024) + c);
                    f32x4 v0 = acc[ai][bj][m][0], v1 = acc[ai][bj][m][1];
                    v0[0] *= bf_lo(g.x); v0[1] *= bf_hi(g.x); v0[2] *= bf_lo(g.y); v0[3] *= bf_hi(g.y);
                    v1[0] *= bf_lo(g.z); v1[1] *= bf_hi(g.z); v1[2] *= bf_lo(g.w); v1[3] *= bf_hi(g.w);
                    if (ADD) { const u32x4 o = *(const u32x4*)(U + r * 1024 + c);
                        v0[0] += bf_lo(o.x); v0[1] += bf_hi(o.x); v0[2] += bf_lo(o.y); v0[3] += bf_hi(o.y);
                        v1[0] += bf_lo(o.z); v1[1] += bf_hi(o.z); v1[2] += bf_lo(o.w); v1[3] += bf_hi(o.w); }
                    *(u32x4*)(U + r * 1024 + c) = pack8(v0, v1); } }
    }
};
struct EpiMix {
    static constexpr bool PERM = false, AFTER_DRAIN = false;
    const float* X; float* H; float alpha;
    __device__ __forceinline__ void operator()(const f32x4 (&acc)[2][2][4][2], const Unit& u, int wr, int wc, int fr, int fq) const {
        const int row0 = u.pm * BM + wr * 64 + fr, col0 = u.pn * BM + wc * 32 + 4 * fq;
#pragma unroll
        for (int ai = 0; ai < 2; ++ai)
#pragma unroll
            for (int m = 0; m < 4; ++m) { const size_t off = (size_t)(row0 + ai * HALF + m * 16) * 1024 + col0;
#pragma unroll
                for (int bj = 0; bj < 2; ++bj)
#pragma unroll
                    for (int n = 0; n < 2; ++n) { const f32x4 xv = *(const f32x4*)(X + off + bj * HALF + n * 16); *(f32x4*)(H + off + bj * HALF + n * 16) = xv * alpha + acc[ai][bj][m][n]; } }
    }
};
struct EpiFF1 {
    static constexpr bool PERM = true, AFTER_DRAIN = false;
    bf16_t* F; const float* bias;
    __device__ __forceinline__ void operator()(const f32x4 (&acc)[2][2][4][2], const Unit& u, int wr, int wc, int fr, int fq) const {
        const int row0 = u.pm * BM + wr * 64 + fr, col0 = u.pn * BM + wc * 32 + 8 * fq;
        f32x4 bv[2][2];
#pragma unroll
        for (int bj = 0; bj < 2; ++bj)
#pragma unroll
            for (int n = 0; n < 2; ++n) bv[bj][n] = *(const f32x4*)(bias + col0 + bj * HALF + 4 * n);
#pragma unroll
        for (int ai = 0; ai < 2; ++ai)
#pragma unroll
            for (int m = 0; m < 4; ++m) { bf16_t* rowp = F + (size_t)(row0 + ai * HALF + m * 16) * 4096 + col0;
#pragma unroll
                for (int bj = 0; bj < 2; ++bj) { f32x4 v0 = acc[ai][bj][m][0] + bv[bj][0], v1 = acc[ai][bj][m][1] + bv[bj][1];
#pragma unroll
                    for (int e = 0; e < 4; ++e) { const float a = fmaxf(v0[e], 0.f), b = fmaxf(v1[e], 0.f); v0[e] = a * a; v1[e] = b * b; }
                    *(u32x4*)(rowp + bj * HALF) = pack8(v0, v1); } }
    }
};
struct EpiFF2 {
    static constexpr bool PERM = false, AFTER_DRAIN = false;
    const float* HPRE; const float* stats; const float* g1; const float* bt1; const float* b2; float* OUT; float alpha;
    __device__ __forceinline__ void operator()(const f32x4 (&acc)[2][2][4][2], const Unit& u, int wr, int wc, int fr, int fq) const {
        typedef float f32x2v __attribute__((ext_vector_type(2)));
        const int row0 = u.pm * BM + wr * 64 + fr, col0 = u.pn * BM + wc * 32 + 4 * fq;
        f32x4 c1[2][2], c0[2][2];
#pragma unroll
        for (int bj = 0; bj < 2; ++bj)
#pragma unroll
            for (int n = 0; n < 2; ++n) { const int c = col0 + bj * HALF + n * 16; c1[bj][n] = *(const f32x4*)(g1 + c) * alpha; c0[bj][n] = *(const f32x4*)(bt1 + c) * alpha + *(const f32x4*)(b2 + c); }
#pragma unroll
        for (int ai = 0; ai < 2; ++ai)
#pragma unroll
            for (int m = 0; m < 4; ++m) { const size_t r = (size_t)(row0 + ai * HALF + m * 16); const f32x2v st = *(const f32x2v*)(stats + 2 * r); const size_t off = r * 1024 + col0;
#pragma unroll
                for (int bj = 0; bj < 2; ++bj)
#pragma unroll
                    for (int n = 0; n < 2; ++n) { const f32x4 hp = *(const f32x4*)(HPRE + off + bj * HALF + n * 16);
                        *(f32x4*)(OUT + off + bj * HALF + n * 16) = acc[ai][bj][m][n] + c0[bj][n] + ((hp - st.x) * st.y) * c1[bj][n]; } }
    }
};
template <class Epi, class Sched, bool ALIGN_EPI = false, bool SP2 = false>
__device__ __forceinline__ void gemm_phase(PG8_LAS unsigned char* lds, const Gemm g, const Sched& S, const Epi& E) {
    const int tid = threadIdx.x, wid = __builtin_amdgcn_readfirstlane(tid >> 6), lane = tid & 63, wr = wid >> 2, wc = wid & 3, fr = lane & 15, fq = lane >> 4;
    const int K = g.K, nt = K / BK;
    unsigned voffA[2], voffB[2];
#pragma unroll
    for (int i = 0; i < 2; ++i) { int R, C; stage_rc(tid * 16 + i * 8192, R, C); const int Rb = Epi::PERM ? ((R & ~31) + perm32(R & 31)) : R;
        voffA[i] = (unsigned)(R * K + C) * 2u; voffB[i] = (unsigned)(Rb * K + C) * 2u; }
    const size_t kstep = (size_t)(BK * 2);
    const size_t hstep = (size_t)HALF * K * 2;
    const size_t tstep = 2 * hstep;
    const unsigned ldsw = (unsigned)wid * 1024u;
    const int aoff = lds_byte(wr * 64 + fr, fq * 8), boff = lds_byte(wc * 32 + fr, fq * 8);
#define PG8_SA(b, h) (((b) * 2 + (h)) * HTB)
#define PG8_SB(b, h) ((4 + (b) * 2 + (h)) * HTB)
#define PG8_STAGE(bufoff, gbase, voff) do { _Pragma("unroll") for (int _i = 0; _i < 2; ++_i) \
        __builtin_amdgcn_global_load_lds((const unsigned*)((const char*)(gbase) + (voff)[_i]), (PG8_LAS unsigned*)(lds + (bufoff) + ldsw + _i * 8192), 16, 0, 0); } while (0)
#define PG8_LDA(dst, b, h) do { _Pragma("unroll") for (int m = 0; m < 4; ++m) _Pragma("unroll") for (int k = 0; k < 2; ++k) dst[m][k] = *(const PG8_LAS bf16x8*)(lds + PG8_SA(b, h) + aoff + m * 2048 + k * 1024); } while (0)
#define PG8_LDB(dst, b, h) do { _Pragma("unroll") for (int n = 0; n < 2; ++n) _Pragma("unroll") for (int k = 0; k < 2; ++k) dst[n][k] = *(const PG8_LAS bf16x8*)(lds + PG8_SB(b, h) + boff + n * 2048 + k * 1024); } while (0)
#define PG8_MMA(ai, bj, At, Bt) do { __builtin_amdgcn_s_setprio(1); _Pragma("unroll") for (int m = 0; m < 4; ++m) _Pragma("unroll") for (int n = 0; n < 2; ++n) _Pragma("unroll") for (int k = 0; k < 2; ++k) \
        acc[ai][bj][m][n] = __builtin_amdgcn_mfma_f32_16x16x32_bf16(Bt[n][k], At[m][k], acc[ai][bj][m][n], 0, 0, 0); __builtin_amdgcn_s_setprio(0); } while (0)
#define PG8_WAIT_V(n) asm volatile("s_waitcnt vmcnt(" #n ")" ::: "memory")
#define PG8_WAIT_L(n) asm volatile("s_waitcnt lgkmcnt(" #n ")" ::: "memory")
#define PG8_BAR __builtin_amdgcn_s_barrier()
#define PG8_SCHED __builtin_amdgcn_sched_barrier(0)
    Unit cur, nxt; int ui = 0;
    if (!S.next(0, cur)) return;
    f32x4 acc[2][2][4][2];
#pragma unroll
    for (int a = 0; a < 2; ++a)
#pragma unroll
        for (int b = 0; b < 2; ++b)
#pragma unroll
            for (int m = 0; m < 4; ++m)
#pragma unroll
                for (int n = 0; n < 2; ++n) acc[a][b][m][n] = (f32x4){0.f, 0.f, 0.f, 0.f};
    bf16x8 At[4][2], B0[2][2], B1[2][2];
    const char* cA = (const char*)g.A + (size_t)cur.pm * tstep; const char* cB = (const char*)g.Bt + (size_t)cur.pn * tstep;
    S.a_ready(cur);
    if constexpr (SP2) {
        PG8_STAGE(PG8_SB(0, 0), cB, voffB); PG8_STAGE(PG8_SB(0, 1), cB + hstep, voffB); PG8_STAGE(PG8_SA(0, 0), cA, voffA); PG8_STAGE(PG8_SA(0, 1), cA + hstep, voffA);
        if (wr == 1) PG8_BAR;
        PG8_WAIT_V(2); PG8_BAR;
        PG8_STAGE(PG8_SB(1, 0), cB + kstep, voffB); PG8_STAGE(PG8_SA(1, 0), cA + kstep, voffA); PG8_STAGE(PG8_SB(1, 1), cB + hstep + kstep, voffB);
        PG8_WAIT_V(6); PG8_BAR;
    } else {
        PG8_STAGE(PG8_SB(0, 0), cB, voffB); PG8_STAGE(PG8_SA(0, 0), cA, voffA); PG8_STAGE(PG8_SB(0, 1), cB + hstep, voffB); PG8_STAGE(PG8_SA(0, 1), cA + hstep, voffA);
        if (wr == 1) PG8_BAR;
        PG8_WAIT_V(4); PG8_BAR;
        PG8_STAGE(PG8_SB(1, 0), cB + kstep, voffB); PG8_STAGE(PG8_SA(1, 0), cA + kstep, voffA); PG8_STAGE(PG8_SB(1, 1), cB + hstep + kstep, voffB);
        PG8_WAIT_V(6); PG8_BAR;
    }
    for (;;) {
        const bool has_next = S.next(ui + 1, nxt);
        const char* nA = has_next ? (const char*)g.A + (size_t)nxt.pm * tstep : cA; const char* nB = has_next ? (const char*)g.Bt + (size_t)nxt.pn * tstep : cB;
        for (int t = 0; t < nt; t += 2) {
            const bool last = (t == nt - 2);
            const char* a1 = cA + (size_t)(t + 1) * kstep;
            const char* a2 = last ? nA : cA + (size_t)(t + 2) * kstep; const char* b2 = last ? nB : cB + (size_t)(t + 2) * kstep;
            const char* a3 = a2 + kstep; const char* b3 = b2 + kstep;
            if (last && has_next) S.a_ready(nxt);
            if constexpr (SP2) {
            PG8_LDB(B0, 0, 0); PG8_LDB(B1, 0, 1); PG8_SCHED; PG8_LDA(At, 0, 0); PG8_STAGE(PG8_SA(1, 1), a1 + hstep, voffA);
            PG8_WAIT_V(8); PG8_WAIT_L(0); PG8_BAR; PG8_MMA(0, 0, At, B0); PG8_MMA(0, 1, At, B1); PG8_BAR; PG8_SCHED;
            PG8_LDA(At, 0, 1); PG8_STAGE(PG8_SB(0, 0), b2, voffB); PG8_STAGE(PG8_SB(0, 1), b2 + hstep, voffB); PG8_STAGE(PG8_SA(0, 0), a2, voffA);
            PG8_WAIT_V(8); PG8_WAIT_L(0); PG8_BAR; PG8_MMA(1, 0, At, B0); PG8_MMA(1, 1, At, B1); PG8_BAR; PG8_SCHED;
            PG8_LDB(B0, 1, 0); PG8_LDB(B1, 1, 1); PG8_SCHED; PG8_LDA(At, 1, 0); PG8_STAGE(PG8_SA(0, 1), a2 + hstep, voffA);
            PG8_WAIT_V(8); PG8_WAIT_L(0); PG8_BAR; PG8_MMA(0, 0, At, B0); PG8_MMA(0, 1, At, B1); PG8_BAR; PG8_SCHED;
            PG8_LDA(At, 1, 1); PG8_STAGE(PG8_SB(1, 0), b3, voffB); PG8_STAGE(PG8_SB(1, 1), b3 + hstep, voffB); PG8_STAGE(PG8_SA(1, 0), a3, voffA);
            PG8_WAIT_V(8); PG8_WAIT_L(0); PG8_BAR; PG8_MMA(1, 0, At, B0); PG8_MMA(1, 1, At, B1); PG8_BAR; PG8_SCHED;
            } else {
            PG8_LDB(B0, 0, 0); PG8_SCHED; PG8_LDA(At, 0, 0); PG8_STAGE(PG8_SA(1, 1), a1 + hstep, voffA);
            PG8_WAIT_L(8); PG8_BAR; PG8_WAIT_L(0); PG8_MMA(0, 0, At, B0); PG8_BAR; PG8_SCHED;
            PG8_LDB(B1, 0, 1); PG8_STAGE(PG8_SB(0, 0), b2, voffB);
            PG8_BAR; PG8_WAIT_L(0); PG8_MMA(0, 1, At, B1); PG8_BAR;
            PG8_LDA(At, 0, 1); PG8_STAGE(PG8_SA(0, 0), a2, voffA);
            PG8_BAR; PG8_WAIT_L(0); PG8_MMA(1, 0, At, B0); PG8_BAR; PG8_SCHED;
            PG8_STAGE(PG8_SB(0, 1), b2 + hstep, voffB);
            PG8_WAIT_V(6); PG8_BAR; PG8_MMA(1, 1, At, B1); PG8_BAR;
            PG8_LDB(B0, 1, 0); PG8_SCHED; PG8_LDA(At, 1, 0); PG8_STAGE(PG8_SA(0, 1), a2 + hstep, voffA);
            PG8_WAIT_L(8); PG8_BAR; PG8_WAIT_L(0); PG8_MMA(0, 0, At, B0); PG8_BAR; PG8_SCHED;
            PG8_LDB(B1, 1, 1); PG8_STAGE(PG8_SB(1, 0), b3, voffB);
            PG8_BAR; PG8_WAIT_L(0); PG8_MMA(0, 1, At, B1); PG8_BAR;
            PG8_LDA(At, 1, 1); PG8_STAGE(PG8_SA(1, 0), a3, voffA);
            PG8_BAR; PG8_WAIT_L(0); PG8_MMA(1, 0, At, B0); PG8_BAR; PG8_SCHED;
            PG8_STAGE(PG8_SB(1, 1), b3 + hstep, voffB);
            PG8_WAIT_V(6); PG8_BAR; PG8_MMA(1, 1, At, B1); PG8_BAR;
            }
        }
        if constexpr (ALIGN_EPI) { if (wr == 0) PG8_BAR; }
        if constexpr (!Epi::AFTER_DRAIN) { E(acc, cur, wr, wc, fr, fq); S.done(cur); }
        if (!has_next) break;
#pragma unroll
        for (int a = 0; a < 2; ++a)
#pragma unroll
            for (int b = 0; b < 2; ++b)
#pragma unroll
                for (int m = 0; m < 4; ++m)
#pragma unroll
                    for (int n = 0; n < 2; ++n) acc[a][b][m][n] = (f32x4){0.f, 0.f, 0.f, 0.f};
        cur = nxt; cA = nA; cB = nB; ++ui;
        if constexpr (ALIGN_EPI) { if (wr == 1) PG8_BAR; }
    }
    PG8_WAIT_V(0);
    if constexpr (!ALIGN_EPI) { if (wr == 0) PG8_BAR; }
    PG8_BAR;
    if constexpr (Epi::AFTER_DRAIN) { E.fused(acc, cur, wr, wc, fr, fq, lds, wid, lane); S.done(cur); }
#undef PG8_SA
#undef PG8_SB
#undef PG8_STAGE
#undef PG8_LDA
#undef PG8_LDB
#undef PG8_MMA
#undef PG8_WAIT_V
#undef PG8_WAIT_L
#undef PG8_BAR
#undef PG8_SCHED
}
}
constexpr int NWAVES = 8;
constexpr int SEQ = 8192, NB = 4, D = 1024, NH = 8, HD = 64, WA = 512, FF = 4096, NCOL = 4096, BLK = 256, NBLK = SEQ / BLK;
constexpr int M = MROWS;
constexpr float LN_EPS = 1e-5f;
constexpr float ALPHA = 1.189207115002721f;
constexpr float LOG2E = 1.4426950408889634f;
constexpr float QSCALE = 0.125f * LOG2E;
constexpr size_t MiB = 1u << 20;
constexpr size_t WS_CTL = 0, CTL_ZERO_BYTES = 1 * MiB;
constexpr size_t WS_KSUM = 512 * 1024;
constexpr size_t WS_STATS = 1 * MiB;
constexpr size_t WS_WIN = 4 * MiB, WS_WOA = 12 * MiB, WS_WPB = 13 * MiB, WS_WOUT = 14 * MiB, WS_W1 = 16 * MiB, WS_W2 = 24 * MiB;
constexpr size_t WS_XB = 32 * MiB;
constexpr size_t WS_QKVP = 96 * MiB;
constexpr size_t WS_G = 224 * MiB;
constexpr size_t WS_POOLED = 352 * MiB, WS_ATT = 384 * MiB, WS_U = 416 * MiB;
constexpr size_t WS_HPRE = 32 * MiB;
constexpr size_t WS_HB = 160 * MiB;
constexpr size_t WS_F = 224 * MiB;
constexpr size_t WS_END = 480 * MiB;
constexpr int CW_BAR = 4096;
constexpr int RING_OFF = 0, RING_BYTES = 131072;
constexpr int LDSCTL_OFF = RING_BYTES, MISC_OFF = LDSCTL_OFF + 320;
constexpr int LDS_BYTES = 147456;

#define GAS __attribute__((address_space(1)))
#define LAS __attribute__((address_space(3)))
typedef unsigned short bf16;
typedef unsigned v4u __attribute__((ext_vector_type(4)));
typedef float f32x4 __attribute__((ext_vector_type(4)));
typedef GAS unsigned gu32;
#define LDS_WAIT() asm volatile("s_waitcnt lgkmcnt(0)" ::: "memory")
#define VM_WAIT() asm volatile("s_waitcnt vmcnt(0)" ::: "memory")
__device__ __forceinline__ unsigned f2bf(float f) { unsigned u = __builtin_bit_cast(unsigned, f); return (u + 0x7fffu + ((u >> 16) & 1u)) >> 16; }
__device__ __forceinline__ unsigned pk2(float lo, float hi) { return f2bf(lo) | (f2bf(hi) << 16); }
__device__ __forceinline__ float bflo(unsigned w) { return __uint_as_float(w << 16); }
__device__ __forceinline__ float bfhi(unsigned w) { return __uint_as_float(w & 0xffff0000u); }
#define XB_TMO      128
#define XB_XCNT(j)  (256  + 64 * (j))
#define XB_XSUB(j)  (1280 + 64 * (j))
#define XB_XGEN(j)  (2304 + 64 * (j))
#define XB_TOP      3328
#define XB_TOPGEN   3392
#define XCD_BAR_WORDS 3456
#define XB_SPIN_CAP (1u << 24)

__device__ __forceinline__ unsigned xb_ld(unsigned* p)              { return __hip_atomic_load(p, __ATOMIC_RELAXED, __HIP_MEMORY_SCOPE_AGENT); }
__device__ __forceinline__ unsigned xb_add(unsigned* p, unsigned v) { return __hip_atomic_fetch_add(p, v, __ATOMIC_RELAXED, __HIP_MEMORY_SCOPE_AGENT); }
__device__ __forceinline__ unsigned xb_xcc_id() { return (unsigned)__builtin_amdgcn_s_getreg((3 << 11) | 20) & 0xFu; }
#define XB_SPIN(cond, bar) do { unsigned _sp = 0; while (cond) { __builtin_amdgcn_s_sleep(1); \
    if ((++_sp & 255u) == 0u) { if (xb_ld(&(bar)[XB_TMO])) break; if (_sp > XB_SPIN_CAP) { atomicAdd(&(bar)[XB_TMO], 1u); break; } } } } while (0)

struct XcdBarrier {
    unsigned* bar; unsigned x;
    volatile LAS unsigned* st;
};

__device__ __forceinline__ XcdBarrier xcd_barrier_post(unsigned* bar, volatile LAS unsigned* st) {
    XcdBarrier b; b.bar = bar; b.x = xb_xcc_id(); b.st = st;
    if (threadIdx.x == 0) (void)xb_add(&bar[XB_XCNT(b.x)], 1u);
    return b;
}
__device__ __forceinline__ void xcd_barrier_complete(unsigned* bar, unsigned x, unsigned& nloc, unsigned& nx) {
    const unsigned G = gridDim.x * gridDim.y * gridDim.z;
    unsigned sum, cnt, mine, sp = 0u;
    for (;;) {
        sum = 0u; cnt = 0u; mine = 0u;
#pragma unroll
        for (unsigned j = 0; j < 16; ++j) { const unsigned c = xb_ld(&bar[XB_XCNT(j)]); sum += c; cnt += (c > 0u) ? 1u : 0u; mine = (j == x) ? c : mine; }
        if (sum == G) break;
        __builtin_amdgcn_s_sleep(1);
        if ((++sp & 255u) == 0u) { if (xb_ld(&bar[XB_TMO])) break; if (sp > XB_SPIN_CAP) { atomicAdd(&bar[XB_TMO], 1u); break; } }
    }
    nloc = mine > 0u ? mine : 1u; nx = cnt > 0u ? cnt : 1u;
}

__device__ __forceinline__ void xcd_barrier(const XcdBarrier& b) {
    asm volatile("s_waitcnt vmcnt(0)" ::: "memory");
    __syncthreads();
    if (threadIdx.x == 0) {
        unsigned* bar = b.bar;
        __builtin_amdgcn_s_waitcnt(0);
        unsigned nloc = b.st[0], nx = b.st[1];
        if (nloc == 0u) { xcd_barrier_complete(bar, b.x, nloc, nx); b.st[0] = nloc; b.st[1] = nx; }
        const unsigned old = xb_add(&bar[XB_XSUB(b.x)], 1u);
        const unsigned gen = old / nloc;
        if (old + 1u == (gen + 1u) * nloc) {
            __builtin_amdgcn_fence(__ATOMIC_RELEASE, "agent");
            asm volatile("s_waitcnt vmcnt(0)" ::: "memory");
            const unsigned og = xb_add(&bar[XB_TOP], 1u);
            const unsigned tg = og / nx;
            if (og + 1u == (tg + 1u) * nx) xb_add(&bar[XB_TOPGEN], 1u);
            else XB_SPIN(xb_ld(&bar[XB_TOPGEN]) == tg, bar);
            __builtin_amdgcn_fence(__ATOMIC_ACQUIRE, "agent");
            xb_add(&bar[XB_XGEN(b.x)], 1u);
            asm volatile("s_waitcnt vmcnt(0)" ::: "memory");
        } else {
            XB_SPIN(xb_ld(&bar[XB_XGEN(b.x)]) == gen, bar);
            __builtin_amdgcn_fence(__ATOMIC_ACQUIRE, "agent");
            asm volatile("s_waitcnt vmcnt(0)" ::: "memory");
        }
    }
    __syncthreads();
}
#ifndef REP_ATTOWN
#define REP_ATTOWN 1
#endif
#ifndef REP_SEL
#define REP_SEL 1
#endif
#ifndef REP_OWN
#define REP_OWN 1
#endif
#ifndef REP_P0
#define REP_P0 1
#endif
#ifndef REP_P1
#define REP_P1 1
#endif
#ifndef REP_P6
#define REP_P6 1
#endif
#ifndef REP_LN1
#define REP_LN1 1
#endif
#ifndef REP_POOL
#define REP_POOL 1
#endif
#ifndef N_LAUNCHES
#define N_LAUNCHES 1
#endif
struct Args { const float* in[17]; float* out; unsigned char* ws; int ph_lo, ph_hi; };
struct Frame {
    LAS unsigned char* lds; volatile LAS unsigned* MISC; gu32* ctl;
    int tid, lane, wave, vcu, G;
};
__device__ __forceinline__ float wave_sum(float v) {
#pragma unroll
    for (int o = 1; o < 64; o <<= 1) v += __shfl_xor(v, o);
    return v;
}
__device__ __forceinline__ float wave_max(float v) {
#pragma unroll
    for (int o = 1; o < 64; o <<= 1) v = fmaxf(v, __shfl_xor(v, o));
    return v;
}
__device__ __forceinline__ void p0_transpose_item(const float* W, int K, int N, bf16* WT, LAS float* scr, int item, int lane) {
    const int nblk = N / 32, kb = item / nblk, nb = item % nblk, k0 = 64 * kb, n0 = 32 * nb;
#pragma unroll 8
    for (int i = 0; i < 32; ++i) { const int kk = 2 * i + (lane >> 5); scr[kk * 33 + (lane & 31)] = W[(size_t)(k0 + kk) * N + n0 + (lane & 31)]; }
    LDS_WAIT(); asm volatile("" ::: "memory");
    const int c = lane & 7;
#pragma unroll
    for (int j = 0; j < 4; ++j) { const int n = (lane >> 3) + 8 * j; const LAS float* s = scr + (8 * c) * 33 + n;
        v4u o; o.x = pk2(s[0 * 33], s[1 * 33]); o.y = pk2(s[2 * 33], s[3 * 33]); o.z = pk2(s[4 * 33], s[5 * 33]); o.w = pk2(s[6 * 33], s[7 * 33]);
        *(GAS v4u*)(WT + (size_t)(n0 + n) * K + k0 + 8 * c) = o; }
    LDS_WAIT(); asm volatile("" ::: "memory");
}
__device__ __forceinline__ void p0_wpb_item(const float* wpool, const float* pscale, const float* wop, bf16* WT, int item, int lane) {
    const int nb = item & 15, kb = item >> 4, n = nb * 64 + lane, k0 = kb * 8, g = k0 >> 7, c0 = k0 & 127;
    float acc[8];
#pragma unroll
    for (int i = 0; i < 8; ++i) acc[i] = 0.f;
    const float* wp = wpool + ((size_t)g * 128 + c0) * 128;
    for (int d0 = 0; d0 < 128; d0 += 16) {
        float wo[16];
#pragma unroll
        for (int dd = 0; dd < 16; ++dd) wo[dd] = wop[(size_t)(g * 128 + d0 + dd) * 1024 + n] * pscale[g * 128 + d0 + dd];
#pragma unroll
        for (int dd = 0; dd < 16; ++dd)
#pragma unroll
            for (int i = 0; i < 8; ++i) acc[i] += wp[i * 128 + d0 + dd] * wo[dd];
    }
    v4u o; o.x = pk2(acc[0], acc[1]); o.y = pk2(acc[2], acc[3]); o.z = pk2(acc[4], acc[5]); o.w = pk2(acc[6], acc[7]);
    *(GAS v4u*)(WT + (size_t)n * 512 + k0) = o;
}
__device__ __forceinline__ void p0_prologue(Frame& F, const Args& a) {
    unsigned char* ws = a.ws;
    LAS float* scr = (LAS float*)(F.lds + RING_OFF + F.wave * 16384);
    const int gw = F.vcu * NWAVES + F.wave, NGW = F.G * NWAVES;
    constexpr int I_IN = (D / 64) * (NCOL / 32), I_OA = (WA / 64) * (D / 32), I_OUT = (D / 64) * (D / 32), I_1 = (D / 64) * (FF / 32), I_2 = (FF / 64) * (D / 32), I_PB = 16 * 64;
    constexpr int NITEMS = I_IN + I_OA + I_OUT + I_1 + I_2 + I_PB;
    for (int it = gw; it < NITEMS; it += NGW) {
        int r = it;
        if (r < I_IN) { p0_transpose_item(a.in[1], D, NCOL, (bf16*)(ws + WS_WIN), scr, r, F.lane); continue; } r -= I_IN;
        if (r < I_OA) { p0_transpose_item(a.in[6], WA, D, (bf16*)(ws + WS_WOA), scr, r, F.lane); continue; } r -= I_OA;
        if (r < I_OUT) { p0_transpose_item(a.in[8], D, D, (bf16*)(ws + WS_WOUT), scr, r, F.lane); continue; } r -= I_OUT;
        if (r < I_1) { p0_transpose_item(a.in[11], D, FF, (bf16*)(ws + WS_W1), scr, r, F.lane); continue; } r -= I_1;
        if (r < I_2) { p0_transpose_item(a.in[13], FF, D, (bf16*)(ws + WS_W2), scr, r, F.lane); continue; } r -= I_2;
        p0_wpb_item(a.in[4], a.in[5], a.in[7], (bf16*)(ws + WS_WPB), r, F.lane);
    }
    const GAS f32x4* xs = (const GAS f32x4*)a.in[0]; GAS v4u* xd = (GAS v4u*)(ws + WS_XB);
    for (size_t i = (size_t)gw * 64 + F.lane; i < (size_t)M * D / 8; i += (size_t)NGW * 64) {
        const f32x4 v0 = xs[2 * i], v1 = xs[2 * i + 1];
        v4u o; o.x = pk2(v0.x, v0.y); o.y = pk2(v0.z, v0.w); o.z = pk2(v1.x, v1.y); o.w = pk2(v1.z, v1.w); xd[i] = o;
    }
}
__device__ __forceinline__ void pooled_phase(Frame& F, const bf16* P, bf16* PO) {
    const int gw = F.vcu * NWAVES + F.wave, NGW = F.G * NWAVES;
    const int w = 2 << (F.lane >> 4);
    for (int grp = gw; grp < M / 16; grp += NGW) {
        const int m0 = grp * 16, t0 = m0 & (SEQ - 1);
        const GAS v4u* src = (const GAS v4u*)(P + (size_t)m0 * 512) + F.lane;
        v4u row[31];
#pragma unroll
        for (int k = 0; k < 31; ++k) { const int tt = t0 - 15 + k; row[k] = (tt >= 0) ? src[(long)(k - 15) * 64] : (v4u){0u, 0u, 0u, 0u}; }
#pragma unroll
        for (int r = 0; r < 16; ++r) {
            const int t = t0 + r; const int cnt = (t + 1) < w ? (t + 1) : w;
            float s[8];
#pragma unroll
            for (int i = 0; i < 8; ++i) s[i] = 0.f;
#pragma unroll
            for (int j = 0; j < 16; ++j) {
                if (j < cnt) { const v4u v = row[15 + r - j];
                    s[0] += bflo(v.x); s[1] += bfhi(v.x); s[2] += bflo(v.y); s[3] += bfhi(v.y); s[4] += bflo(v.z); s[5] += bfhi(v.z); s[6] += bflo(v.w); s[7] += bfhi(v.w); }
            }
            const v4u c = row[15 + r]; const float fc = 1.0f / (float)cnt;
            v4u o; o.x = pk2(s[0] * fc - bflo(c.x), s[1] * fc - bfhi(c.x)); o.y = pk2(s[2] * fc - bflo(c.y), s[3] * fc - bfhi(c.y));
            o.z = pk2(s[4] * fc - bflo(c.z), s[5] * fc - bfhi(c.z)); o.w = pk2(s[6] * fc - bflo(c.w), s[7] * fc - bfhi(c.w));
            *((GAS v4u*)(PO + (size_t)(m0 + r) * 512) + F.lane) = o;
        }
    }
}
template <int MODE> __device__ __forceinline__ void ln_rows(Frame& F, float* X, const float* gam, const float* bet, bf16* OB, float* stats) {
    const int gw = F.vcu * NWAVES + F.wave, NGW = F.G * NWAVES;
    f32x4 gv[4], bv[4];
#pragma unroll
    for (int j = 0; j < 4; ++j) { gv[j] = ((const GAS f32x4*)gam)[F.lane + 64 * j]; bv[j] = ((const GAS f32x4*)bet)[F.lane + 64 * j]; }
    for (int m = gw; m < M; m += NGW) {
        GAS f32x4* xr = (GAS f32x4*)(X + (size_t)m * D) + F.lane;
        f32x4 v[4]; float s = 0.f;
#pragma unroll
        for (int j = 0; j < 4; ++j) { v[j] = xr[64 * j]; s += (v[j].x + v[j].y) + (v[j].z + v[j].w); }
        const float mean = wave_sum(s) * (1.f / D); float s2 = 0.f;
#pragma unroll
        for (int j = 0; j < 4; ++j) { v[j] = v[j] - mean; s2 += (v[j].x * v[j].x + v[j].y * v[j].y) + (v[j].z * v[j].z + v[j].w * v[j].w); }
        const float rstd = 1.f / sqrtf(wave_sum(s2) * (1.f / D) + LN_EPS);
        if (MODE == 0) {
            GAS unsigned long long* o8 = (GAS unsigned long long*)(OB + (size_t)m * D) + F.lane;
#pragma unroll
            for (int j = 0; j < 4; ++j) { const f32x4 o = v[j] * rstd * gv[j] + bv[j]; o8[64 * j] = (unsigned long long)pk2(o.x, o.y) | ((unsigned long long)pk2(o.z, o.w) << 32); }
            if (F.lane == 0) { stats[2 * (size_t)m] = mean; stats[2 * (size_t)m + 1] = rstd; }
        } else {
#pragma unroll
            for (int j = 0; j < 4; ++j) xr[64 * j] = v[j] * rstd * gv[j] + bv[j];
        }
    }
}
__device__ __forceinline__ int rel_bucket_dev(int n) {
    if (n < 16) return n;
    const int bd[15] = {19, 21, 24, 27, 31, 35, 40, 46, 52, 59, 67, 77, 87, 99, 113};
    int b = 16;
#pragma unroll
    for (int i = 0; i < 15; ++i) b += (n >= bd[i]) ? 1 : 0;
    return b;
}
__device__ __forceinline__ void attn_naive_phase(Frame& F, const bf16* Q, const bf16* K, const bf16* V, const float* ksum, const float* rel_table, bf16* ATT) {
    LAS float* lut = (LAS float*)(F.lds + RING_OFF);
    for (int i = F.tid; i < NH * 128; i += NWAVES * 64) { const int h = i >> 7, n = i & 127; lut[i] = rel_table[rel_bucket_dev(n) * NH + h] * LOG2E; }
    __syncthreads();
    const int gw = F.vcu * NWAVES + F.wave, NGW = F.G * NWAVES, lane = F.lane;
    for (int task = gw; task < M * NH; task += NGW) {
        const int m = task >> 3, h = task & 7, b = m >> 13, t = m & (SEQ - 1), ib = t >> 8;
        float q[64];
        { const GAS v4u* qp = (const GAS v4u*)(Q + (size_t)m * 512 + h * 64);
#pragma unroll
          for (int c = 0; c < 8; ++c) { const v4u v = qp[c]; q[8 * c] = bflo(v.x); q[8 * c + 1] = bfhi(v.x); q[8 * c + 2] = bflo(v.y); q[8 * c + 3] = bfhi(v.y); q[8 * c + 4] = bflo(v.z); q[8 * c + 5] = bfhi(v.z); q[8 * c + 6] = bflo(v.w); q[8 * c + 7] = bfhi(v.w); } }
        float g = -3.0e38f;
        if (lane < ib) { const GAS f32x4* kp = (const GAS f32x4*)(ksum + (size_t)(b * NBLK + lane) * 512 + h * 64); float a = 0.f;
#pragma unroll
            for (int c = 0; c < 16; ++c) { const f32x4 v = kp[c]; a += q[4 * c] * v.x + q[4 * c + 1] * v.y + q[4 * c + 2] * v.z + q[4 * c + 3] * v.w; }
            g = a; }
        int sel[4]; const int nsel = ib < 3 ? ib : 3;
#pragma unroll
        for (int s = 0; s < 3; ++s) {
            float bv = g; int bi = lane;
#pragma unroll
            for (int o = 1; o < 64; o <<= 1) { const float ov = __shfl_xor(bv, o); const int oi = __shfl_xor(bi, o); if (ov > bv || (ov == bv && oi < bi)) { bv = ov; bi = oi; } }
            sel[s] = bi; if (lane == bi) g = -3.0e38f;
        }
        sel[3] = ib;
        float sc[16];
#pragma unroll
        for (int s = 0; s < 4; ++s) {
            const bool valid = (s == 3) || (s < nsel);
            const int jb = (s == 3) ? ib : sel[s];
#pragma unroll
            for (int kk = 0; kk < 4; ++kk) {
                float v = -1.0e30f;
                if (valid) {
                    const int key = jb * BLK + kk * 64 + lane;
                    const GAS v4u* kp = (const GAS v4u*)(K + ((size_t)b * SEQ + key) * 512 + h * 64); float a = 0.f;
#pragma unroll
                    for (int c = 0; c < 8; ++c) { const v4u w = kp[c]; a += q[8 * c] * bflo(w.x) + q[8 * c + 1] * bfhi(w.x) + q[8 * c + 2] * bflo(w.y) + q[8 * c + 3] * bfhi(w.y) + q[8 * c + 4] * bflo(w.z) + q[8 * c + 5] * bfhi(w.z) + q[8 * c + 6] * bflo(w.w) + q[8 * c + 7] * bfhi(w.w); }
                    const int dist = t - key;
                    if (dist >= 0) v = a + lut[h * 128 + (dist < 127 ? dist : 127)];
                }
                sc[s * 4 + kk] = v;
            }
        }
        float mx = sc[0];
#pragma unroll
        for (int i = 1; i < 16; ++i) mx = fmaxf(mx, sc[i]);
        mx = wave_max(mx);
        float l = 0.f;
#pragma unroll
        for (int i = 0; i < 16; ++i) { sc[i] = __builtin_amdgcn_exp2f(sc[i] - mx); l += sc[i]; }
        l = wave_sum(l);
        float o = 0.f;
#pragma unroll
        for (int s = 0; s < 4; ++s) {
            const bool valid = (s == 3) || (s < nsel);
            if (valid) {
                const int jb = (s == 3) ? ib : sel[s];
#pragma unroll
                for (int kk = 0; kk < 4; ++kk) {
                    const bf16* vp = V + ((size_t)b * SEQ + jb * BLK + kk * 64) * 512 + h * 64 + lane;
                    const float pr = sc[s * 4 + kk];
                    for (int l2 = 0; l2 < 64; ++l2) { const float p = __shfl(pr, l2); o += p * __uint_as_float((unsigned)vp[(size_t)l2 * 512] << 16); }
                }
            }
        }
        ATT[(size_t)m * 512 + h * 64 + lane] = (bf16)f2bf(o / l);
    }
    __syncthreads();
}
namespace moba {
typedef short bf16x8 __attribute__((ext_vector_type(8)));
typedef float f32x16 __attribute__((ext_vector_type(16)));
typedef short s16x4 __attribute__((ext_vector_type(4)));
typedef short v4i16_t __attribute__((ext_vector_type(4)));
typedef unsigned u32x4 __attribute__((ext_vector_type(4)));
typedef float f32x2_t __attribute__((ext_vector_type(2))); typedef __bf16 bf16x2_t __attribute__((ext_vector_type(2)));
constexpr int LK = 0, LV = 32768, LSTG = 65536, LSCR = 98304, LLUT = 106496, LPRE = 110592, LCNTL = 114816, LEND = 118912;
constexpr int LIST_PER_BH = 126976;
constexpr int CW_LCNT = 16384;
constexpr size_t OUT_PO = 0, OUT_ML = 96u << 20, OUT_LIST = 104u << 20;
__device__ __forceinline__ int crow(int r, int hi) { return (r & 3) + 8 * (r >> 2) + 4 * hi; }
__device__ __forceinline__ unsigned cvtpk(float lo, float hi) { f32x2_t v = {lo, hi}; bf16x2_t b = __builtin_convertvector(v, bf16x2_t); return __builtin_bit_cast(unsigned, b); }
__device__ __forceinline__ int list_off(int j) { return 256 * (31 * j - (j * (j - 1)) / 2); }
__device__ __forceinline__ s16x4 vtr(const LAS unsigned char* p) { return __builtin_bit_cast(s16x4, __builtin_amdgcn_ds_read_tr16_b64_v4i16((LAS v4i16_t*)p)); }

__device__ __forceinline__ void load_kv_block(const bf16* Kg, const bf16* Vg, LAS unsigned char* lds, int wave, int lane) {
#pragma unroll
    for (int i = 0; i < 4; ++i) {
        const int p = wave * 4 + i;
        { const int c = p & 7, g = p >> 3; const bf16* src = Kg + (size_t)(g * 64 + lane) * 512 + c * 8;
          __builtin_amdgcn_global_load_lds((const unsigned*)src, (LAS unsigned*)(lds + LK + c * 4096 + g * 1024), 16, 0, 0); }
        { const int dh = p >> 4, rg = p & 15; const bf16* src = Vg + (size_t)(rg * 16 + (lane >> 2)) * 512 + dh * 32 + (lane & 3) * 8;
          __builtin_amdgcn_global_load_lds((const unsigned*)src, (LAS unsigned*)(lds + LV + dh * 16384 + rg * 1024), 16, 0, 0); }
    }
}
__device__ __forceinline__ float bias_of(const float* rel_table, int h, int x) { return x < 0 ? 0.f : rel_table[rel_bucket_dev(x > 127 ? 127 : x) * NH + h] * LOG2E; }
__device__ __forceinline__ void build_tb(LAS f32x4* tb, const float* rel_table, int h, int tid) {
    if (tid < 256) { f32x4 v; v.x = bias_of(rel_table, h, tid); v.y = bias_of(rel_table, h, tid - 1); v.z = bias_of(rel_table, h, tid - 2); v.w = bias_of(rel_table, h, tid - 3); tb[tid] = v; }
}
template <bool OWN>
__device__ __forceinline__ void attend(const bf16x8 (&qr)[4], const LAS unsigned char* lds, const LAS f32x4* tb, int dbase, bool use_lut, int ktmax,
                                       int r32, int hi, int lane, f32x16 (&o)[2], float& m_out, float& l_out) {
    f32x16 st[8];
    const LAS unsigned char* kp = lds + LK + hi * 4096 + r32 * 16;
#pragma unroll
    for (int kt = 0; kt < 8; ++kt) {
        if (kt <= ktmax) {
            f32x16 acc;
#pragma unroll
            for (int r = 0; r < 16; ++r) acc[r] = 0.f;
#pragma unroll
            for (int d0 = 0; d0 < 4; ++d0) { const bf16x8 a = *(const LAS bf16x8*)(kp + d0 * 8192 + kt * 512); acc = __builtin_amdgcn_mfma_f32_32x32x16_bf16(a, qr[d0], acc, 0, 0, 0); }
            st[kt] = acc;
        }
    }
    const float c31 = tb[255].x;
    const int dh = dbase - 4 * hi;
    float mx = -3.0e38f;
#pragma unroll
    for (int kt = 0; kt < 8; ++kt) {
        if (kt <= ktmax) {
            if (use_lut) {
#pragma unroll
                for (int g = 0; g < 4; ++g) { const int d = dh - (32 * kt + 8 * g); const f32x4 bv = tb[d > 255 ? 255 : d];
#pragma unroll
                    for (int e = 0; e < 4; ++e) { const float s = st[kt][4 * g + e] + bv[e]; st[kt][4 * g + e] = s; mx = fmaxf(mx, s); } }
            } else {
#pragma unroll
                for (int r = 0; r < 16; ++r) { const float s = st[kt][r] + c31; st[kt][r] = s; mx = fmaxf(mx, s); }
            }
        }
    }
    mx = fmaxf(mx, __shfl_xor(mx, 32));
    float ls = 0.f;
#pragma unroll
    for (int kt = 0; kt < 8; ++kt) {
        if (kt <= ktmax) {
#pragma unroll
            for (int r = 0; r < 16; ++r) { const float p = __builtin_amdgcn_exp2f(st[kt][r] - mx); st[kt][r] = p; ls += p; }
        }
    }
    ls += __shfl_xor(ls, 32);
#pragma unroll
    for (int r = 0; r < 16; ++r) { o[0][r] = 0.f; o[1][r] = 0.f; }
    const LAS unsigned char* vp = lds + LV + ((lane >> 4) & 1) * 32 + (lane & 3) * 8 + (4 * hi + ((lane & 15) >> 2)) * 64;
#pragma unroll
    for (int kt = 0; kt < 8; ++kt) {
        if (kt <= ktmax) {
            u32x4 wa, wb;
            wa.x = cvtpk(st[kt][0], st[kt][1]); wa.y = cvtpk(st[kt][2], st[kt][3]); wa.z = cvtpk(st[kt][4], st[kt][5]); wa.w = cvtpk(st[kt][6], st[kt][7]);
            wb.x = cvtpk(st[kt][8], st[kt][9]); wb.y = cvtpk(st[kt][10], st[kt][11]); wb.z = cvtpk(st[kt][12], st[kt][13]); wb.w = cvtpk(st[kt][14], st[kt][15]);
            const bf16x8 pa = __builtin_bit_cast(bf16x8, wa), pb = __builtin_bit_cast(bf16x8, wb);
#pragma unroll
            for (int d0 = 0; d0 < 2; ++d0) {
                const LAS unsigned char* v0 = vp + d0 * 16384 + kt * 2048;
                const s16x4 l0 = vtr(v0), h0 = vtr(v0 + 512), l1 = vtr(v0 + 1024), h1 = vtr(v0 + 1536);
                const bf16x8 va = (bf16x8){l0[0], l0[1], l0[2], l0[3], h0[0], h0[1], h0[2], h0[3]}, vb = (bf16x8){l1[0], l1[1], l1[2], l1[3], h1[0], h1[1], h1[2], h1[3]};
                o[d0] = __builtin_amdgcn_mfma_f32_32x32x16_bf16(pa, va, o[d0], 0, 0, 0);
                o[d0] = __builtin_amdgcn_mfma_f32_32x32x16_bf16(pb, vb, o[d0], 0, 0, 0);
            }
        }
    }
    m_out = mx; l_out = ls;
}
__device__ __forceinline__ void own_scores(f32x16& acc, const bf16x8 (&qr)[4], const LAS unsigned char* kp, const LAS f32x4* tb, int kt, int ktmax, int dh, float c31) {
#pragma unroll
    for (int r = 0; r < 16; ++r) acc[r] = 0.f;
#pragma unroll
    for (int d0 = 0; d0 < 4; ++d0) { const bf16x8 a = *(const LAS bf16x8*)(kp + d0 * 8192 + kt * 512); acc = __builtin_amdgcn_mfma_f32_32x32x16_bf16(a, qr[d0], acc, 0, 0, 0); }
    if (ktmax - kt >= 5) {
#pragma unroll
        for (int r = 0; r < 16; ++r) acc[r] += c31;
    } else {
#pragma unroll
        for (int g = 0; g < 4; ++g) { const int d = dh - (32 * kt + 8 * g); const f32x4 bv = tb[d < 0 ? 0 : d];
#pragma unroll
            for (int e = 0; e < 4; ++e) acc[4 * g + e] += bv[e]; }
        if (kt == ktmax) {
#pragma unroll
            for (int r = 0; r < 16; ++r) { const int dist = dh - (32 * kt + (r & 3) + 8 * (r >> 2)); if (dist < 0) acc[r] = -1.0e30f; }
        }
    }
}
__device__ __forceinline__ void attend_own(const bf16x8 (&qr)[4], const LAS unsigned char* lds, const LAS f32x4* tb, int dbase, int ktmax,
                                           int r32, int hi, int lane, f32x16 (&o)[2], float& m_out, float& l_out) {
    const LAS unsigned char* kp = lds + LK + hi * 4096 + r32 * 16;
    const int dh = dbase - 4 * hi; const float c31 = tb[255].x;
    float mx = -3.0e38f;
    for (int kt = 0; kt <= ktmax; ++kt) {
        f32x16 acc; own_scores(acc, qr, kp, tb, kt, ktmax, dh, c31);
#pragma unroll
        for (int r = 0; r < 16; ++r) mx = fmaxf(mx, acc[r]);
    }
    mx = fmaxf(mx, __shfl_xor(mx, 32));
    float ls = 0.f;
#pragma unroll
    for (int r = 0; r < 16; ++r) { o[0][r] = 0.f; o[1][r] = 0.f; }
    const LAS unsigned char* vp = lds + LV + ((lane >> 4) & 1) * 32 + (lane & 3) * 8 + (4 * hi + ((lane & 15) >> 2)) * 64;
    for (int kt = 0; kt <= ktmax; ++kt) {
        f32x16 acc; own_scores(acc, qr, kp, tb, kt, ktmax, dh, c31);
#pragma unroll
        for (int r = 0; r < 16; ++r) { const float p = __builtin_amdgcn_exp2f(acc[r] - mx); acc[r] = p; ls += p; }
        u32x4 wa, wb;
        wa.x = cvtpk(acc[0], acc[1]); wa.y = cvtpk(acc[2], acc[3]); wa.z = cvtpk(acc[4], acc[5]); wa.w = cvtpk(acc[6], acc[7]);
        wb.x = cvtpk(acc[8], acc[9]); wb.y = cvtpk(acc[10], acc[11]); wb.z = cvtpk(acc[12], acc[13]); wb.w = cvtpk(acc[14], acc[15]);
        const bf16x8 pa = __builtin_bit_cast(bf16x8, wa), pb = __builtin_bit_cast(bf16x8, wb);
#pragma unroll
        for (int d0 = 0; d0 < 2; ++d0) {
            const LAS unsigned char* v0 = vp + d0 * 16384 + kt * 2048;
            const s16x4 l0 = vtr(v0), h0 = vtr(v0 + 512), l1 = vtr(v0 + 1024), h1 = vtr(v0 + 1536);
            const bf16x8 va = (bf16x8){l0[0], l0[1], l0[2], l0[3], h0[0], h0[1], h0[2], h0[3]}, vb = (bf16x8){l1[0], l1[1], l1[2], l1[3], h1[0], h1[1], h1[2], h1[3]};
            o[d0] = __builtin_amdgcn_mfma_f32_32x32x16_bf16(pa, va, o[d0], 0, 0, 0);
            o[d0] = __builtin_amdgcn_mfma_f32_32x32x16_bf16(pb, vb, o[d0], 0, 0, 0);
        }
    }
    ls += __shfl_xor(ls, 32);
    m_out = mx; l_out = ls;
}
__device__ __forceinline__ void stage_o(const f32x16 (&o)[2], LAS unsigned short* stg, const LAS float* rowf, int r32, int hi) {
#pragma unroll
    for (int r = 0; r < 16; ++r) { const int row = crow(r, hi); const float f = rowf[row];
#pragma unroll
        for (int d0 = 0; d0 < 2; ++d0) stg[row * 64 + d0 * 32 + r32] = (unsigned short)(cvtpk(o[d0][r] * f, 0.f) & 0xffffu); }
}

__device__ __forceinline__ void gate_phase(Frame& F, const bf16* Q, const float* ksum, unsigned* lcnt, unsigned* lists) {
    LAS unsigned* cnt = (LAS unsigned*)(F.lds + RING_OFF + LSCR);
    const int lane = F.lane, r32 = lane & 31, hi = lane >> 5, w = F.wave;
    for (int k = 0; k < 4; ++k) {
        const int u = F.vcu * 4 + k, bh = u >> 5, ib = u & 31, b = bh >> 3, h = bh & 7;
        if (F.tid < 64) cnt[F.tid] = 0u;
        __syncthreads();
        const int t = ib * 256 + 32 * w + r32; const size_t m = (size_t)b * SEQ + t;
        bf16x8 qr[4];
#pragma unroll
        for (int d0 = 0; d0 < 4; ++d0) qr[d0] = *(const bf16x8*)(Q + m * 512 + h * 64 + 16 * d0 + 8 * hi);
        f32x16 g;
#pragma unroll
        for (int r = 0; r < 16; ++r) g[r] = 0.f;
        const float* kr = ksum + (size_t)(b * NBLK + r32) * 512 + h * 64 + 8 * hi;
#pragma unroll
        for (int d0 = 0; d0 < 4; ++d0) {
            const f32x4 a0 = *(const f32x4*)(kr + 16 * d0), a1 = *(const f32x4*)(kr + 16 * d0 + 4);
            const float e[8] = {a0.x, a0.y, a0.z, a0.w, a1.x, a1.y, a1.z, a1.w};
            u32x4 wh, wl;
            unsigned hh[8], ll[8];
#pragma unroll
            for (int i = 0; i < 8; ++i) { hh[i] = f2bf(e[i]); ll[i] = f2bf(e[i] - __uint_as_float(hh[i] << 16)); }
            wh.x = hh[0] | (hh[1] << 16); wh.y = hh[2] | (hh[3] << 16); wh.z = hh[4] | (hh[5] << 16); wh.w = hh[6] | (hh[7] << 16);
            wl.x = ll[0] | (ll[1] << 16); wl.y = ll[2] | (ll[3] << 16); wl.z = ll[4] | (ll[5] << 16); wl.w = ll[6] | (ll[7] << 16);
            g = __builtin_amdgcn_mfma_f32_32x32x16_bf16(__builtin_bit_cast(bf16x8, wh), qr[d0], g, 0, 0, 0);
            g = __builtin_amdgcn_mfma_f32_32x32x16_bf16(__builtin_bit_cast(bf16x8, wl), qr[d0], g, 0, 0, 0);
        }
        float v[16];
#pragma unroll
        for (int r = 0; r < 16; ++r) v[r] = (crow(r, hi) < ib) ? g[r] : -3.0e38f;
        float tv[3]; int ti[3];
#pragma unroll
        for (int s = 0; s < 3; ++s) {
            float bv = v[0]; int br = 0;
#pragma unroll
            for (int r = 1; r < 16; ++r) if (v[r] > bv) { bv = v[r]; br = r; }
            tv[s] = bv; ti[s] = crow(br, hi);
#pragma unroll
            for (int r = 0; r < 16; ++r) if (r == br) v[r] = -3.4e38f;
        }
        float cv[6]; int ci[6];
#pragma unroll
        for (int s = 0; s < 3; ++s) { cv[s] = tv[s]; ci[s] = ti[s]; cv[3 + s] = __shfl_xor(tv[s], 32); ci[3 + s] = __shfl_xor(ti[s], 32); }
        int sel[3];
#pragma unroll
        for (int s = 0; s < 3; ++s) {
            float bv = cv[0]; int bi = ci[0];
#pragma unroll
            for (int c = 1; c < 6; ++c) if (cv[c] > bv || (cv[c] == bv && ci[c] < bi)) { bv = cv[c]; bi = ci[c]; }
            sel[s] = bi;
#pragma unroll
            for (int c = 0; c < 6; ++c) if (ci[c] == bi) cv[c] = -3.4e38f;
        }
        const int nsel = ib < 3 ? ib : 3;
        unsigned pos[3];
#pragma unroll
        for (int s = 0; s < 3; ++s) { pos[s] = 0u; if (hi == 0 && s < nsel) pos[s] = __hip_atomic_fetch_add(cnt + sel[s], 1u, __ATOMIC_RELAXED, __HIP_MEMORY_SCOPE_WORKGROUP); }
        __syncthreads();
        if (F.tid < 32) { const unsigned c = cnt[F.tid]; cnt[32 + F.tid] = c ? __hip_atomic_fetch_add(lcnt + bh * 32 + F.tid, c, __ATOMIC_RELAXED, __HIP_MEMORY_SCOPE_AGENT) : 0u; }
        __syncthreads();
#pragma unroll
        for (int s = 0; s < 3; ++s) if (hi == 0 && s < nsel) { const int j = sel[s]; lists[(size_t)bh * LIST_PER_BH + list_off(j) + cnt[32 + j] + pos[s]] = (unsigned)t | ((unsigned)s << 13); }
        __syncthreads();
    }
}
__device__ __forceinline__ void sel_phase(Frame& F, const bf16* Q, const bf16* K, const bf16* V, const float* rel_table, const unsigned* lcnt, const unsigned* lists, bf16* PO, float* ML) {
    LAS unsigned char* lds = F.lds + RING_OFF;
    LAS f32x4* tb = (LAS f32x4*)(lds + LLUT); LAS int* pre = (LAS int*)(lds + LPRE); LAS int* cntl = (LAS int*)(lds + LCNTL);
    const int lane = F.lane, r32 = lane & 31, hi = lane >> 5, w = F.wave, tid = F.tid;
    LAS float* scr = (LAS float*)(lds + LSCR) + w * 256; LAS unsigned short* stg = (LAS unsigned short*)(lds + LSTG + w * 4096);
    {
        const int n0 = (int)lcnt[2 * tid], n1 = (int)lcnt[2 * tid + 1]; const int c0 = (n0 + 255) >> 8, c1 = (n1 + 255) >> 8;
        cntl[2 * tid] = n0; cntl[2 * tid + 1] = n1;
        int s = c0 + c1;
#pragma unroll
        for (int o = 1; o < 64; o <<= 1) { const int y = __shfl_up(s, o); if (lane >= o) s += y; }
        LAS int* wsum = (LAS int*)(lds + LSCR);
        if (lane == 63) wsum[w] = s;
        __syncthreads();
        int base = 0;
#pragma unroll
        for (int i = 0; i < 8; ++i) if (i < w) base += wsum[i];
        const int excl = base + s - (c0 + c1);
        pre[2 * tid] = excl; pre[2 * tid + 1] = excl + c0;
        if (tid == 511) pre[1024] = excl + c0 + c1;
        __syncthreads();
    }
    const int T = pre[1024];
    const int x0 = (int)(((long)F.vcu * T) / F.G), x1 = (int)(((long)(F.vcu + 1) * T) / F.G);
#define SEL_LOCATE(x, L_, ci_) do { int lo_ = 0, hi__ = 1024; const int xx_ = (x) < x1 ? (x) : x0; while (hi__ - lo_ > 1) { const int mid_ = (lo_ + hi__) >> 1; if (pre[mid_] <= xx_) lo_ = mid_; else hi__ = mid_; } L_ = lo_; ci_ = xx_ - pre[lo_]; } while (0)
#define SEL_ENTRY(L_, ci_) ({ const int n_ = cntl[L_]; const int first_ = (ci_) * 256 + w * 32; const int idx_ = first_ + r32; const int li_ = first_ < n_ ? (idx_ < n_ ? idx_ : first_) : 0; lists[(size_t)((L_) >> 5) * LIST_PER_BH + list_off((L_) & 31) + li_]; })
#define SEL_LOADQ(dst, L_, e_) do { const size_t m_ = (size_t)((L_) >> 8) * SEQ + (int)((e_) & 8191u); const bf16* qp_ = Q + m_ * 512 + (((L_) >> 5) & 7) * 64 + 8 * hi; \
        _Pragma("unroll") for (int d0_ = 0; d0_ < 4; ++d0_) dst[d0_] = *(const bf16x8*)(qp_ + 16 * d0_); } while (0)
    if (x0 < x1) {
        int L0, c0, L1, c1, L2, c2;
        SEL_LOCATE(x0, L0, c0); SEL_LOCATE(x0 + 1, L1, c1);
        unsigned e0 = SEL_ENTRY(L0, c0), e1 = SEL_ENTRY(L1, c1), e2;
        bf16x8 q0[4], q1[4];
        SEL_LOADQ(q0, L0, e0);
        int curL = -1;
        for (int x = x0; x < x1; ++x) {
            SEL_LOADQ(q1, L1, e1);
            SEL_LOCATE(x + 2, L2, c2); e2 = SEL_ENTRY(L2, c2);
            const int L = L0, ci = c0, n = cntl[L], b = L >> 8, h = (L >> 5) & 7, j = L & 31;
            if (L != curL) {
                __syncthreads();
                load_kv_block(K + ((size_t)b * SEQ + j * BLK) * 512 + h * 64, V + ((size_t)b * SEQ + j * BLK) * 512 + h * 64, lds, w, lane);
                if (curL < 0 || ((curL >> 5) & 7) != h) build_tb(tb, rel_table, h, tid);
                asm volatile("s_waitcnt vmcnt(0)" ::: "memory");
                __syncthreads();
                curL = L;
            }
            const int first = ci * 256 + w * 32;
            if (first < n) {
                const int idx = first + r32; const bool valid = idx < n;
                const int t = (int)(e0 & 8191u), slot = (int)(e0 >> 13); const size_t m = (size_t)b * SEQ + t;
                const int dbase = t - j * BLK;
                const bool use_lut = __any((dbase - 255) < 113);
                f32x16 o[2]; float mx, ls;
                attend<false>(q0, lds, tb, dbase, use_lut, 7, r32, hi, lane, o, mx, ls);
                const int dst = valid ? (int)((size_t)slot * ((size_t)M * NH) + m * NH + h) : -1;
                if (hi == 0) { scr[r32] = 1.0f / ls; ((LAS int*)scr)[32 + r32] = dst; if (valid) { ML[2 * (size_t)dst] = mx; ML[2 * (size_t)dst + 1] = ls; } }
                stage_o(o, stg, scr, r32, hi);
#pragma unroll
                for (int i = 0; i < 4; ++i) { const int row = i * 8 + (lane >> 3), ch = lane & 7; const u32x4 vv = *(const LAS u32x4*)(stg + row * 64 + ch * 8); const int d = ((LAS int*)scr)[32 + row];
                    if (d >= 0) *(u32x4*)(PO + (size_t)d * 64 + ch * 8) = vv; }
            }
            L0 = L1; c0 = c1; L1 = L2; c1 = c2; e0 = e1; e1 = e2;
#pragma unroll
            for (int d0 = 0; d0 < 4; ++d0) q0[d0] = q1[d0];
        }
    }
#undef SEL_LOCATE
#undef SEL_ENTRY
#undef SEL_LOADQ
    __syncthreads();
}
__device__ __forceinline__ void own_phase(Frame& F, const bf16* Q, const bf16* K, const bf16* V, const float* rel_table, const bf16* PO, const float* ML, bf16* ATT) {
    LAS unsigned char* lds = F.lds + RING_OFF;
    LAS f32x4* tb = (LAS f32x4*)(lds + LLUT);
    const int lane = F.lane, r32 = lane & 31, hi = lane >> 5, w = F.wave, tid = F.tid;
    const int tile = w < 4 ? w : 11 - w;
    LAS float* scr = (LAS float*)(lds + LSCR) + w * 256; LAS unsigned short* stg = (LAS unsigned short*)(lds + LSTG + w * 4096);
    typedef float f32x2v __attribute__((ext_vector_type(2)));
#define OWN_DECODE(k_, b_, h_, ib_) const int u_##k_ = F.vcu * 4 + (k_); const int b_ = (u_##k_ >> 5) >> 3, h_ = (u_##k_ >> 5) & 7, ib_ = u_##k_ & 31
    u32x4 kvr[8]; bf16x8 qc[4], qn[4];
    { OWN_DECODE(0, b, h, ib);
      __syncthreads();
      load_kv_block(K + ((size_t)b * SEQ + ib * BLK) * 512 + h * 64, V + ((size_t)b * SEQ + ib * BLK) * 512 + h * 64, lds, w, lane);
      const size_t m = (size_t)b * SEQ + ib * BLK + tile * 32 + r32;
#pragma unroll
      for (int d0 = 0; d0 < 4; ++d0) qc[d0] = *(const bf16x8*)(Q + m * 512 + h * 64 + 16 * d0 + 8 * hi);
      build_tb(tb, rel_table, h, tid);
      asm volatile("s_waitcnt vmcnt(0)" ::: "memory");
      __syncthreads(); }
    for (int k = 0; k < 4; ++k) {
        const int u = F.vcu * 4 + k, bh = u >> 5, ib = u & 31, b = bh >> 3, h = bh & 7;
        const int nsel = ib < 3 ? ib : 3;
        const int tl = tile * 32 + r32; const size_t m = (size_t)b * SEQ + ib * BLK + tl;
        if (k < 3) {
            const int un = u + 1, bn = (un >> 5) >> 3, hn = (un >> 5) & 7, ibn = un & 31;
            const bf16* Kg = K + ((size_t)bn * SEQ + ibn * BLK) * 512 + hn * 64; const bf16* Vg = V + ((size_t)bn * SEQ + ibn * BLK) * 512 + hn * 64;
#pragma unroll
            for (int i = 0; i < 4; ++i) { const int p = w * 4 + i;
                kvr[2 * i] = *(const u32x4*)(Kg + (size_t)((p >> 3) * 64 + lane) * 512 + (p & 7) * 8);
                kvr[2 * i + 1] = *(const u32x4*)(Vg + (size_t)((p & 15) * 16 + (lane >> 2)) * 512 + (p >> 4) * 32 + (lane & 3) * 8); }
            const size_t mn = (size_t)bn * SEQ + ibn * BLK + tl;
#pragma unroll
            for (int d0 = 0; d0 < 4; ++d0) qn[d0] = *(const bf16x8*)(Q + mn * 512 + hn * 64 + 16 * d0 + 8 * hi);
        }
        f32x2v mlv[3];
#pragma unroll
        for (int s = 0; s < 3; ++s) { mlv[s] = (f32x2v){-3.0e38f, 0.f}; if (s < nsel) mlv[s] = *(const f32x2v*)(ML + 2 * ((size_t)s * ((size_t)M * NH) + m * NH + h)); }
        f32x16 o[2]; float mx, ls;
        for (int rep = 0; rep < REP_ATTOWN; ++rep) { asm volatile("" ::: "memory"); attend_own(qc, lds, tb, tl, tile, r32, hi, lane, o, mx, ls); }
        if (hi == 0) {
            float Mx = mx;
#pragma unroll
            for (int s = 0; s < 3; ++s) Mx = fmaxf(Mx, mlv[s].x);
            const float wo = ls * __builtin_amdgcn_exp2f(mx - Mx); float tot = wo; float wsel[3];
#pragma unroll
            for (int s = 0; s < 3; ++s) { wsel[s] = (s < nsel) ? mlv[s].y * __builtin_amdgcn_exp2f(mlv[s].x - Mx) : 0.f; tot += wsel[s]; }
            const float inv = 1.0f / tot;
            scr[r32] = (wo * inv) / ls;
#pragma unroll
            for (int s = 0; s < 3; ++s) scr[64 + r32 * 4 + s] = wsel[s] * inv;
        }
        stage_o(o, stg, scr, r32, hi);
#pragma unroll
        for (int i = 0; i < 4; ++i) {
            const int row = i * 8 + (lane >> 3), ch = lane & 7; const size_t mr = (size_t)b * SEQ + ib * BLK + tile * 32 + row;
            const u32x4 own = *(const LAS u32x4*)(stg + row * 64 + ch * 8);
            float a[8] = {bflo(own.x), bfhi(own.x), bflo(own.y), bfhi(own.y), bflo(own.z), bfhi(own.z), bflo(own.w), bfhi(own.w)};
#pragma unroll
            for (int s = 0; s < 3; ++s) if (s < nsel) { const float ws = scr[64 + row * 4 + s]; const u32x4 p = *(const u32x4*)(PO + ((size_t)s * ((size_t)M * NH) + mr * NH + h) * 64 + ch * 8);
                a[0] += ws * bflo(p.x); a[1] += ws * bfhi(p.x); a[2] += ws * bflo(p.y); a[3] += ws * bfhi(p.y); a[4] += ws * bflo(p.z); a[5] += ws * bfhi(p.z); a[6] += ws * bflo(p.w); a[7] += ws * bfhi(p.w); }
            u32x4 ov; ov.x = cvtpk(a[0], a[1]); ov.y = cvtpk(a[2], a[3]); ov.z = cvtpk(a[4], a[5]); ov.w = cvtpk(a[6], a[7]);
            *(u32x4*)(ATT + mr * 512 + h * 64 + ch * 8) = ov;
        }
        if (k < 3) {
            __syncthreads();
#pragma unroll
            for (int i = 0; i < 4; ++i) { const int p = w * 4 + i;
                *(LAS u32x4*)(lds + LK + (p & 7) * 4096 + (p >> 3) * 1024 + lane * 16) = kvr[2 * i];
                *(LAS u32x4*)(lds + LV + (p >> 4) * 16384 + (p & 15) * 1024 + lane * 16) = kvr[2 * i + 1]; }
#pragma unroll
            for (int d0 = 0; d0 < 4; ++d0) qc[d0] = qn[d0];
            __syncthreads();
        }
    }
#undef OWN_DECODE
    __syncthreads();
}
}
constexpr int N_PHASES = 11;
__global__ void __launch_bounds__(NWAVES * 64, 2) moba_fwd(Args args) {
    extern __shared__ __attribute__((aligned(16))) unsigned char lds[];
    const int ph_lo = args.ph_lo, ph_hi = args.ph_hi;
#define IN(k) (ph_lo <= (k) && (k) < ph_hi)
#define BOTH(k) (IN(k) && IN((k) + 1))
    Frame F;
    F.lds = (LAS unsigned char*)lds;
    F.MISC = (volatile LAS unsigned*)(F.lds + MISC_OFF);
    F.tid = threadIdx.x; F.lane = F.tid & 63; F.wave = __builtin_amdgcn_readfirstlane(F.tid >> 6);
    F.G = gridDim.x; { const int bx = blockIdx.x; F.vcu = (F.G % 8 == 0) ? (bx % 8) * (F.G / 8) + bx / 8 : bx; }
    unsigned char* ws = args.ws;
    F.ctl = (gu32*)(ws + WS_CTL);
    for (int u = F.tid; u < (LDS_BYTES - LDSCTL_OFF) / 4; u += NWAVES * 64) ((LAS unsigned*)(F.lds + LDSCTL_OFF))[u] = 0u;
    __syncthreads();
    XcdBarrier bar; bar.bar = (unsigned*)(F.ctl + CW_BAR); bar.x = 0; bar.st = nullptr;
    if (ph_hi - ph_lo > 1) bar = xcd_barrier_post((unsigned*)(F.ctl + CW_BAR), F.MISC + 8);
#define GRID_BAR(k) do { if (BOTH(k)) xcd_barrier(bar); } while (0)
    bf16* const Win_t = (bf16*)(ws + WS_WIN); bf16* const Woa_t = (bf16*)(ws + WS_WOA); bf16* const Wpb_t = (bf16*)(ws + WS_WPB);
    bf16* const Wout_t = (bf16*)(ws + WS_WOUT); bf16* const W1_t = (bf16*)(ws + WS_W1); bf16* const W2_t = (bf16*)(ws + WS_W2);
    bf16* const XB = (bf16*)(ws + WS_XB); bf16* const QKVP = (bf16*)(ws + WS_QKVP); bf16* const GT = (bf16*)(ws + WS_G);
    bf16* const POOLED = (bf16*)(ws + WS_POOLED); bf16* const ATT = (bf16*)(ws + WS_ATT); bf16* const U = (bf16*)(ws + WS_U);
    float* const HPRE = (float*)(ws + WS_HPRE); bf16* const HB = (bf16*)(ws + WS_HB); bf16* const FB = (bf16*)(ws + WS_F);
    float* const KSUM = (float*)(ws + WS_KSUM); float* const STATS = (float*)(ws + WS_STATS);
    const bf16* Qb = QKVP; const bf16* Kb = QKVP + (size_t)M * 512; const bf16* Vb = QKVP + (size_t)2 * M * 512; const bf16* Pb = QKVP + (size_t)3 * M * 512;
    unsigned* const LCNT = (unsigned*)(F.ctl + moba::CW_LCNT);
    unsigned char* const ob = (unsigned char*)args.out;
    bf16* const PO = (bf16*)(ob + moba::OUT_PO); float* const ML = (float*)(ob + moba::OUT_ML); unsigned* const LISTS = (unsigned*)(ob + moba::OUT_LIST);

    if (IN(0)) { for (int rep = 0; rep < REP_P0; ++rep) p0_prologue(F, args); GRID_BAR(0); }
    if (IN(1)) { pg8::Gemm g{XB, Win_t, M, NCOL, D}; pg8::StaticOrder S; S.init(M, NCOL, F.G, (int)blockIdx.x);
      pg8::EpiProj E{QKVP, GT, args.in[2], KSUM, QSCALE};
      for (int rep = 0; rep < REP_P1; ++rep) pg8::gemm_phase<pg8::EpiProj, pg8::StaticOrder, true, true>(F.lds + RING_OFF, g, S, E); GRID_BAR(1); }
    if (IN(2)) { for (int rep = 0; rep < REP_POOL; ++rep) pooled_phase(F, Pb, POOLED);
#if !defined(ATTN_NAIVE)
      moba::gate_phase(F, Qb, KSUM, LCNT, LISTS);
#endif
      GRID_BAR(2); }
    if (IN(3)) { { pg8::Gemm g{POOLED, Wpb_t, M, D, WA}; pg8::StaticOrder S; S.init(M, D, F.G, (int)blockIdx.x);
      pg8::EpiBranch<false> E{U, GT};
      pg8::gemm_phase<pg8::EpiBranch<false>, pg8::StaticOrder, true, true>(F.lds + RING_OFF, g, S, E); }
#if defined(ATTN_NAIVE)
      attn_naive_phase(F, Qb, Kb, Vb, KSUM, args.in[3], ATT);
#else
      for (int rep = 0; rep < REP_SEL; ++rep) moba::sel_phase(F, Qb, Kb, Vb, args.in[3], LCNT, LISTS, PO, ML);
#endif
      GRID_BAR(3); }
    if (IN(4)) {
#if !defined(ATTN_NAIVE)
      for (int rep = 0; rep < REP_OWN; ++rep) moba::own_phase(F, Qb, Kb, Vb, args.in[3], PO, ML, ATT);
#endif
#if defined(ATTN_CHECK)
      attn_naive_phase(F, Qb, Kb, Vb, KSUM, args.in[3], (bf16*)(ws + (480u << 20)));
#endif
      GRID_BAR(4); }
#if defined(ATTN_CHECK)
    if (IN(5)) {
        const bf16* R = (const bf16*)(ws + (480u << 20)); const int gw = F.vcu * NWAVES + F.wave, NGW = F.G * NWAVES;
        float sd = 0.f, sr = 0.f, md = 0.f; unsigned nbad = 0u;
        for (size_t i = (size_t)gw * 64 + F.lane; i < (size_t)M * 512; i += (size_t)NGW * 64) { const float a = bflo((unsigned)ATT[i]), r = bflo((unsigned)R[i]); const float d = a - r; sd += d * d; sr += r * r; md = fmaxf(md, fabsf(d)); nbad += (fabsf(d) > 0.004f + 0.02f * fabsf(r)) ? 1u : 0u; }
        sd = wave_sum(sd); sr = wave_sum(sr); md = wave_max(md); nbad = (unsigned)wave_sum((float)nbad);
        if (F.lane == 0) { unsafeAtomicAdd((float*)(F.ctl + 20000), sd); unsafeAtomicAdd((float*)(F.ctl + 20001), sr); atomicMax((unsigned*)(F.ctl + 20002), __float_as_uint(md)); atomicAdd((unsigned*)(F.ctl + 20003), nbad); }
    }
#endif
    if (IN(5)) { pg8::Gemm g{ATT, Woa_t, M, D, WA}; pg8::StaticOrder S; S.init(M, D, F.G, (int)blockIdx.x);
      pg8::EpiBranch<true> E{U, GT};
      pg8::gemm_phase<pg8::EpiBranch<true>, pg8::StaticOrder, true, true>(F.lds + RING_OFF, g, S, E); GRID_BAR(5); }
    if (IN(6)) { pg8::Gemm g{U, Wout_t, M, D, D}; pg8::StaticOrder S; S.init(M, D, F.G, (int)blockIdx.x);
      pg8::EpiMix E{args.in[0], HPRE, ALPHA};
      pg8::gemm_phase<pg8::EpiMix, pg8::StaticOrder, true, true>(F.lds + RING_OFF, g, S, E); GRID_BAR(6); }
    if (IN(7)) { for (int rep = 0; rep < REP_LN1; ++rep) ln_rows<0>(F, HPRE, args.in[9], args.in[10], HB, STATS); GRID_BAR(7); }
    if (IN(8)) { pg8::Gemm g{HB, W1_t, M, FF, D}; pg8::StaticOrder S; S.init(M, FF, F.G, (int)blockIdx.x);
      pg8::EpiFF1 E{FB, args.in[12]};
      pg8::gemm_phase<pg8::EpiFF1, pg8::StaticOrder, true, true>(F.lds + RING_OFF, g, S, E); GRID_BAR(8); }
    if (IN(9)) { pg8::Gemm g{FB, W2_t, M, D, FF}; pg8::StaticOrder S; S.init(M, D, F.G, (int)blockIdx.x);
      pg8::EpiFF2 E{HPRE, STATS, args.in[9], args.in[10], args.in[14], args.out, ALPHA};
      for (int rep = 0; rep < REP_P6; ++rep) pg8::gemm_phase<pg8::EpiFF2, pg8::StaticOrder, true, true>(F.lds + RING_OFF, g, S, E); GRID_BAR(9); }
#if defined(ATTN_CHECK)
    if (IN(10)) { const float sd = ((const float*)(F.ctl + 20000))[0], sr = ((const float*)(F.ctl + 20001))[0], md = ((const float*)(F.ctl + 20002))[0]; const unsigned nb = ((const unsigned*)(F.ctl + 20003))[0];
        float val = 0.f;
        if (ATTN_CHECK == 1) val = 1.0e4f * sqrtf(sd / sr); else if (ATTN_CHECK == 2) val = 1.0e4f * md; else if (ATTN_CHECK == 3) val = (float)nb; else val = 1.0e4f * sqrtf(sr / ((float)M * 512.f));
        const int gw = F.vcu * NWAVES + F.wave, NGW = F.G * NWAVES;
        for (size_t i = (size_t)gw * 64 + F.lane; i < (size_t)M * 1024; i += (size_t)NGW * 64) args.out[i] = val; }
#else
    if (IN(10)) ln_rows<1>(F, args.out, args.in[15], args.in[16], nullptr, nullptr);
#endif
#undef IN
#undef BOTH
}

extern "C" void kernel_launch(void* const* d_in, const int* in_sizes, int n_in, void* d_out, int out_size, void* d_ws, size_t ws_size, hipStream_t stream) {
    static int grid = 0;
    if (grid == 0) {
        if (n_in != 17 || in_sizes[0] != M * D || out_size != M * D || ws_size < (512u << 20)) { fprintf(stderr, "kernel_launch: unexpected shapes (n_in %d, in0 %d, out %d, ws %zu); nothing launched\n", n_in, n_in > 0 ? in_sizes[0] : -1, out_size, ws_size); grid = -1; return; }
        int dev = 0, cus = 0, per_cu = 0;
        if (hipGetDevice(&dev) != hipSuccess || hipDeviceGetAttribute(&cus, hipDeviceAttributeMultiprocessorCount, dev) != hipSuccess) { grid = -1; return; }
        if (hipFuncSetAttribute((const void*)moba_fwd, hipFuncAttributeMaxDynamicSharedMemorySize, LDS_BYTES) != hipSuccess) { fprintf(stderr, "kernel_launch: hipFuncSetAttribute failed\n"); grid = -1; return; }
        if (hipOccupancyMaxActiveBlocksPerMultiprocessor(&per_cu, (const void*)moba_fwd, NWAVES * 64, LDS_BYTES) != hipSuccess || per_cu < 1) { fprintf(stderr, "kernel_launch: occupancy query says %d blocks per CU\n", per_cu); }
        (void)hipGetLastError();
        grid = cus;
    }
    if (grid < 0) return;
    (void)hipMemsetAsync((char*)d_ws + WS_CTL, 0, CTL_ZERO_BYTES, stream);
    Args a{};
    for (int i = 0; i < 17; ++i) a.in[i] = (const float*)d_in[i];
    a.out = (float*)d_out; a.ws = (unsigned char*)d_ws;
#if N_LAUNCHES == 1
    a.ph_lo = 0; a.ph_hi = N_PHASES;
    hipLaunchKernelGGL(moba_fwd, dim3(grid), dim3(NWAVES * 64), LDS_BYTES, stream, a);
#else
    for (int p = 0; p < N_PHASES; ++p) { a.ph_lo = p; a.ph_hi = p + 1; hipLaunchKernelGGL(moba_fwd, dim3(grid), dim3(NWAVES * 64), LDS_BYTES, stream, a); }
#endif
}
```
